# Optimizing an MI355X kernel written in HIP

```python
import math
import jax, jax.numpy as jnp
from jax import lax
import numpy as np

D_MODEL = 1024
BATCH = 8
SEQ = 2048
DEPTH = 2

CHUNK = 64
N_META = 16
Q_BLOCK = 128
N_A = max(1, DEPTH // 2)
N_B = DEPTH - N_A
N_HEADS = 8
A_HEAD_DIM = D_MODEL // N_HEADS
A_KV_HEADS = 2
IDX_HEADS = 8
IDX_DIM = 64
TOPK_MAX = 256
A_Q = N_HEADS * A_HEAD_DIM
A_KV = A_KV_HEADS * A_HEAD_DIM
A_IDXQ = IDX_HEADS * IDX_DIM
A_SPLITS = [A_Q, A_Q + A_KV, A_Q + 2 * A_KV, A_Q + 2 * A_KV + A_IDXQ,
            A_Q + 2 * A_KV + A_IDXQ + IDX_DIM]
A_IN = A_Q + 2 * A_KV + A_IDXQ + IDX_DIM + IDX_HEADS
B_HEAD_DIM = D_MODEL // (2 * N_HEADS)
B_V_DIM = 2 * B_HEAD_DIM
B_Q = 2 * N_HEADS * B_HEAD_DIM
B_KV = 2 * N_HEADS * B_HEAD_DIM + N_HEADS * B_V_DIM
REL_BUCKETS = 32
REL_MAX_DIST = 128
D_FF = 2816
CONV_W = 3
EPS = 1e-6
NEG_INF = -1e30
FAR_CHUNK = 1 << 30

kernel_name = "yoco_dsa_diffattn_convffn_trunk"


def rms_norm(x, g):
    xf = x.astype(jnp.float32)
    y = xf * lax.rsqrt(jnp.mean(xf * xf, axis=-1, keepdims=True) + EPS)
    return (y * g.astype(jnp.float32)).astype(x.dtype)


def chunk_ids(t_pad, t_real):
    pos = jnp.arange(t_pad, dtype=jnp.int32)
    cid = jnp.where(pos < N_META, 0, 1 + (pos - N_META) // CHUNK)
    return jnp.where(pos < t_real, cid, FAR_CHUNK)


def rel_bucket(rel):
    nb = REL_BUCKETS // 2
    max_exact = nb // 2
    n = jnp.abs(rel)
    nf = jnp.maximum(n, 1).astype(jnp.float32)
    large = max_exact + (jnp.log(nf / max_exact) / math.log(REL_MAX_DIST / max_exact)
                         * (nb - max_exact)).astype(jnp.int32)
    large = jnp.minimum(large, nb - 1)
    return jnp.where(rel > 0, nb, 0) + jnp.where(n < max_exact, n, large)


def to_blocks(a, nblk):
    return a.reshape(a.shape[0], nblk, Q_BLOCK, *a.shape[2:]).swapaxes(0, 1)


def dsa_attention(h, w_in, w_o, gq, gk, rel_table, cid, pos, k_top):
    B, Tp, _ = h.shape
    nblk = Tp // Q_BLOCK
    rep = N_HEADS // A_KV_HEADS
    q, k, v, qi, ki, wi = jnp.split(h @ w_in, A_SPLITS, axis=-1)
    q = rms_norm(q.reshape(B, Tp, N_HEADS, A_HEAD_DIM), gq)
    k = rms_norm(k.reshape(B, Tp, A_KV_HEADS, A_HEAD_DIM), gk)
    v = v.reshape(B, Tp, A_KV_HEADS, A_HEAD_DIM)
    qi = qi.reshape(B, Tp, IDX_HEADS, IDX_DIM).astype(jnp.float32)
    ki = ki.astype(jnp.float32)
    wi = wi.astype(jnp.float32) * IDX_HEADS ** -0.5
    table = rel_table.astype(jnp.float32)
    scale = A_HEAD_DIM ** -0.5

    def block(args):
        qb, qib, wib, qpos, qcid = args
        s = jnp.einsum('bqhd,bsd->bqhs', qib, ki) * IDX_DIM ** -0.5
        score = jnp.einsum('bqh,bqhs->bqs', wib, jax.nn.relu(s))
        vis = cid[None, :] <= qcid[:, None]
        score = jnp.where(vis[None], score, NEG_INF)
        _, idx = lax.top_k(score, k_top)
        ksel = jax.vmap(lambda kb, ib: kb[ib])(k, idx)
        vsel = jax.vmap(lambda vb, ib: vb[ib])(v, idx)
        valid = cid[idx] <= qcid[None, :, None]
        bias = table[rel_bucket(idx - qpos[None, :, None])]
        bias = bias.reshape(B, Q_BLOCK, k_top, A_KV_HEADS, rep).transpose(0, 1, 3, 4, 2)
        qg = qb.reshape(B, Q_BLOCK, A_KV_HEADS, rep, A_HEAD_DIM)
        logits = jnp.einsum('bqgrd,bqkgd->bqgrk', qg, ksel).astype(jnp.float32) * scale + bias
        logits = jnp.where(valid[:, :, None, None, :], logits, NEG_INF)
        p = jax.nn.softmax(logits, axis=-1).astype(v.dtype)
        o = jnp.einsum('bqgrk,bqkgd->bqgrd', p, vsel)
        return o.reshape(B, Q_BLOCK, A_Q)

    out = lax.map(block, (to_blocks(q, nblk), to_blocks(qi, nblk), to_blocks(wi, nblk),
                          pos.reshape(nblk, Q_BLOCK), cid.reshape(nblk, Q_BLOCK)))
    out = out.swapaxes(0, 1).reshape(B, Tp, A_Q)
    return out @ w_o


def diff_attention(h, w_q, w_o, gq, sub_g, k1, k2, vb, lam, lam_init, rel_table, cid, pos):
    B, Tp, _ = h.shape
    nblk = Tp // Q_BLOCK
    q = h @ w_q
    q1, q2 = jnp.split(q, 2, axis=-1)
    q1 = rms_norm(q1.reshape(B, Tp, N_HEADS, B_HEAD_DIM), gq)
    q2 = rms_norm(q2.reshape(B, Tp, N_HEADS, B_HEAD_DIM), gq)
    table = rel_table.astype(jnp.float32)
    scale = B_HEAD_DIM ** -0.5

    def block(args):
        q1b, q2b, qpos, qcid = args
        bias = table[rel_bucket(pos[None, :] - qpos[:, None])].transpose(2, 0, 1)
        mask = cid[None, :] <= qcid[:, None]

        def attn_map(qb, kk):
            lg = jnp.einsum('bqhd,bshd->bhqs', qb, kk).astype(jnp.float32) * scale + bias
            return jax.nn.softmax(jnp.where(mask, lg, NEG_INF), axis=-1)

        a = attn_map(q1b, k1) - lam * attn_map(q2b, k2)
        return jnp.einsum('bhqs,bshd->bqhd', a.astype(vb.dtype), vb)

    o = lax.map(block, (to_blocks(q1, nblk), to_blocks(q2, nblk),
                        pos.reshape(nblk, Q_BLOCK), cid.reshape(nblk, Q_BLOCK)))
    o = o.swapaxes(0, 1).reshape(B, Tp, N_HEADS, B_V_DIM)
    o = rms_norm(o, sub_g) * (1.0 - lam_init)
    return o.reshape(B, Tp, N_HEADS * B_V_DIM) @ w_o


def conv_ffn(h, w_up, conv_w, conv_b, w_down):
    Tp = h.shape[1]
    u = h @ w_up
    up = jnp.pad(u, ((0, 0), (CONV_W - 1, 0), (0, 0)))
    c = conv_b + sum(up[:, j:j + Tp] * conv_w[j] for j in range(CONV_W))
    gate, val = jnp.split(c, 2, axis=-1)
    return (jax.nn.silu(gate) * val) @ w_down


def setup_inputs(seed: int = 0) -> dict:
    key = jax.random.key(seed)
    ks = jax.random.split(key, 26)
    f32 = jnp.float32

    def nrm(k, shape, scale):
        return jax.random.normal(k, shape, f32) * scale

    def gain(k, shape):
        return 1.0 + 0.05 * jax.random.normal(k, shape, f32)

    return {
        "x": nrm(ks[0], (BATCH, SEQ, D_MODEL), 1.0),
        "meta_tokens": nrm(ks[1], (N_META, D_MODEL), 1.0),
        "rel_table": nrm(ks[2], (REL_BUCKETS, N_HEADS), 0.5),
        "ln_attn_g": gain(ks[3], (DEPTH, D_MODEL)),
        "ln_ffn_g": gain(ks[4], (DEPTH, D_MODEL)),
        "w_in_a": nrm(ks[5], (N_A, D_MODEL, A_IN), D_MODEL ** -0.5),
        "w_o_a": nrm(ks[6], (N_A, A_Q, D_MODEL), A_Q ** -0.5),
        "qn_a": gain(ks[7], (N_A, A_HEAD_DIM)),
        "kn_a": gain(ks[8], (N_A, A_HEAD_DIM)),
        "kv_norm_g": gain(ks[9], (D_MODEL,)),
        "w_kv_b": nrm(ks[10], (D_MODEL, B_KV), D_MODEL ** -0.5),
        "kn_b": gain(ks[11], (B_HEAD_DIM,)),
        "w_q_b": nrm(ks[12], (N_B, D_MODEL, B_Q), D_MODEL ** -0.5),
        "qn_b": gain(ks[13], (N_B, B_HEAD_DIM)),
        "lam_q1": nrm(ks[14], (N_B, B_HEAD_DIM), 0.1),
        "lam_k1": nrm(ks[15], (N_B, B_HEAD_DIM), 0.1),
        "lam_q2": nrm(ks[16], (N_B, B_HEAD_DIM), 0.1),
        "lam_k2": nrm(ks[17], (N_B, B_HEAD_DIM), 0.1),
        "subln_b": gain(ks[18], (N_B, B_V_DIM)),
        "w_o_b": nrm(ks[19], (N_B, N_HEADS * B_V_DIM, D_MODEL), (N_HEADS * B_V_DIM) ** -0.5),
        "w_up": nrm(ks[20], (DEPTH, D_MODEL, 2 * D_FF), D_MODEL ** -0.5),
        "conv_w": nrm(ks[21], (DEPTH, CONV_W, 2 * D_FF), CONV_W ** -0.5),
        "conv_b": nrm(ks[22], (DEPTH, 2 * D_FF), 0.01),
        "w_down": nrm(ks[23], (DEPTH, D_FF, D_MODEL), D_FF ** -0.5),
    }


def reference(x, meta_tokens, rel_table, ln_attn_g, ln_ffn_g, w_in_a, w_o_a, qn_a, kn_a,
              kv_norm_g, w_kv_b, kn_b, w_q_b, qn_b, lam_q1, lam_k1, lam_q2, lam_k2,
              subln_b, w_o_b, w_up, conv_w, conv_b, w_down):
    B, S, D = x.shape
    T = N_META + S
    Tp = -(-T // Q_BLOCK) * Q_BLOCK
    k_top = min(TOPK_MAX, S // 4)
    h = jnp.concatenate([jnp.broadcast_to(meta_tokens.astype(x.dtype), (B, N_META, D)), x], axis=1)
    h = jnp.pad(h, ((0, 0), (0, Tp - T), (0, 0)))
    cid = chunk_ids(Tp, T)
    pos = jnp.arange(Tp, dtype=jnp.int32)

    k1 = k2 = vb = None
    for i in range(DEPTH):
        if i < N_A:
            h = h + dsa_attention(rms_norm(h, ln_attn_g[i]), w_in_a[i], w_o_a[i], qn_a[i], kn_a[i],
                                  rel_table, cid, pos, k_top)
        else:
            j = i - N_A
            if j == 0:
                kv = rms_norm(h, kv_norm_g) @ w_kv_b
                k1, k2, vb = jnp.split(kv, [N_HEADS * B_HEAD_DIM, 2 * N_HEADS * B_HEAD_DIM], axis=-1)
                k1 = rms_norm(k1.reshape(B, Tp, N_HEADS, B_HEAD_DIM), kn_b)
                k2 = rms_norm(k2.reshape(B, Tp, N_HEADS, B_HEAD_DIM), kn_b)
                vb = vb.reshape(B, Tp, N_HEADS, B_V_DIM)
            lam_init = 0.8 - 0.6 * math.exp(-0.3 * i)
            lam = (jnp.exp(jnp.sum(lam_q1[j].astype(jnp.float32) * lam_k1[j].astype(jnp.float32)))
                   - jnp.exp(jnp.sum(lam_q2[j].astype(jnp.float32) * lam_k2[j].astype(jnp.float32)))
                   + lam_init)
            h = h + diff_attention(rms_norm(h, ln_attn_g[i]), w_q_b[j], w_o_b[j], qn_b[j], subln_b[j],
                                   k1, k2, vb, lam, lam_init, rel_table, cid, pos)
        h = h + conv_ffn(rms_norm(h, ln_ffn_g[i]), w_up[i], conv_w[i], conv_b[i], w_down[i])
    return h[:, N_META:T]
```

```cpp
#define MK_N_LAUNCHES 1
#ifndef PROBE_SEQ
#define PROBE_SEQ 0,1,2,3,4,5,6,7,8,9,10,11,12,13,14,15,16,17,18
#endif
#ifndef PROBE_VAR
#define PROBE_VAR 0
#endif
#ifndef PROBE_VAR_A
#define PROBE_VAR_A 0
#endif
#ifndef PROBE_DRY
#define PROBE_DRY 0
#endif
#ifndef DUP_ATTN
#define DUP_ATTN 0
#endif
#ifndef DUP_SEL
#define DUP_SEL 0
#endif
#include <hip/hip_runtime.h>
#include <cstdio>
#include <cstdint>
namespace pg8 {
#define PG8_LAS __attribute__((address_space(3)))
typedef unsigned short bf16_t;
typedef short bf16x8 __attribute__((ext_vector_type(8)));
typedef float f32x4 __attribute__((ext_vector_type(4)));
typedef unsigned u32x4 __attribute__((ext_vector_type(4)));
constexpr int BM = 256, BK = 64, HALF = 128, HTB = HALF * BK * 2  , STAGE_BYTES = 8 * HTB, NXCD = 8, WGM = 8;

__host__ __device__ __forceinline__ int lds_byte(int r, int c) { const int st = (r >> 4) * 2 + (c >> 5), rr = r & 15, cc = c & 31, ob = rr * 64 + cc * 2; return st * 1024 + (ob ^ (((ob >> 9) & 1) << 5)); }
__host__ __device__ __forceinline__ void stage_rc(int b, int& R, int& C) { const int st = b / 1024, sb = b % 1024, swz = sb ^ (((sb >> 9) & 1) << 5); R = (st >> 1) * 16 + swz / 64; C = (st & 1) * 32 + (swz % 64) / 2; }
__host__ __device__ __forceinline__ int perm32(int rho) { const int n = rho >> 4, i = rho & 15; return 8 * (i >> 2) + 4 * n + (i & 3); }

struct Unit { int pm, pn; };
struct Gemm { const bf16_t* A; const bf16_t* Bt; int M, N, K; };

struct StaticOrder {
    int nM, nN, nwg, G, c;
    __host__ __device__ void init(int M, int N, int G_, int c_) { nM = M / BM; nN = N / BM; nwg = nM * nN; G = G_; c = c_; }
    __host__ __device__ __forceinline__ bool next(int i, Unit& u) const {
        const long L = (long)i * G + c; if (L >= nwg) return false;
        int wgid = (int)L; { const int q = nwg / NXCD, r = nwg % NXCD, xcd = wgid % NXCD, off = wgid / NXCD; wgid = (xcd < r ? xcd * (q + 1) : r * (q + 1) + (xcd - r) * q) + off; }
        const int nig = WGM * nN, gid = wgid / nig, fm = gid * WGM, gsz = (nM - fm) < WGM ? (nM - fm) : WGM;
        u.pm = fm + ((wgid % nig) % gsz); u.pn = (wgid % nig) / gsz; return true;
    }
    __device__ __forceinline__ void a_ready(const Unit&) const {}
    __device__ __forceinline__ void done(const Unit&) const {}
};


constexpr int NREAL = 16384, NVALID = 16400;
__device__ __forceinline__ unsigned cvt_pk_bf16(float lo, float hi) { unsigned r; asm volatile("s_nop 0\n\tv_cvt_pk_bf16_f32 %0, %1, %2" : "=v"(r) : "v"(lo), "v"(hi)); return r; }
typedef unsigned u32x2 __attribute__((ext_vector_type(2)));

__device__ __forceinline__ float row_rstd(const float* ps, int row, int fq) {
    const f32x4 v = *(const f32x4*)(ps + (size_t)row * 16 + 4 * fq); float t = (v[0] + v[1]) + (v[2] + v[3]);
    t += __shfl_xor(t, 16); t += __shfl_xor(t, 32); return __builtin_amdgcn_rsqf(t * (1.f / 1024.f) + 1e-6f);
}
struct EpiBf16G {
    static constexpr bool PERM = true, AFTER_DRAIN = false;
    bf16_t* O; int ldc; int ncols; const float* rs;
    __device__ __forceinline__ void operator()(const f32x4 (&acc)[2][2][4][2], const Unit& u, int wr, int wc, int fr, int fq) const {
        const int row0 = u.pm * BM + wr * 64 + fr, col0 = u.pn * BM + wc * 32 + 8 * fq;
#pragma unroll
        for (int ai = 0; ai < 2; ++ai)
#pragma unroll
            for (int m = 0; m < 4; ++m) { const int row = row0 + ai * HALF + m * 16;
                if (row < NVALID) { bf16_t* rowp = O + (size_t)row * ldc;
                    const float sc = rs ? row_rstd(rs, row, fq) : 1.f;
#pragma unroll
                    for (int bj = 0; bj < 2; ++bj) { const int col = col0 + bj * HALF;
                        if (col < ncols) { const f32x4 v0 = acc[ai][bj][m][0] * sc, v1 = acc[ai][bj][m][1] * sc;
                            u32x4 w; w.x = cvt_pk_bf16(v0[0], v0[1]); w.y = cvt_pk_bf16(v0[2], v0[3]); w.z = cvt_pk_bf16(v1[0], v1[1]); w.w = cvt_pk_bf16(v1[2], v1[3]);
                            *(u32x4*)(rowp + col) = w; } } } }
    }
};
struct EpiKVQ {
    static constexpr bool PERM = true, AFTER_DRAIN = false;
    bf16_t* O; const float* rs; const float* gq; const float* gk; float qscale;
    __device__ __forceinline__ void operator()(const f32x4 (&acc)[2][2][4][2], const Unit& u, int wr, int wc, int fr, int fq) const {
        const int row0 = u.pm * BM + wr * 64 + fr;
        if (u.pn < 8) {
            const float* g = (u.pn < 4 ? gq : gk) + 8 * fq; const float hs = u.pn < 4 ? qscale : 1.f;
            f32x4 gv[2][2];
#pragma unroll
            for (int bj = 0; bj < 2; ++bj)
#pragma unroll
                for (int n = 0; n < 2; ++n) gv[bj][n] = *(const f32x4*)(g + 32 * bj + 4 * n);
            const int colb = (u.pn >> 2) * 1024 + (4 * (u.pn & 3) + wc) * 64 + 8 * fq;
#pragma unroll
            for (int ai = 0; ai < 2; ++ai)
#pragma unroll
                for (int m = 0; m < 4; ++m) { const int row = row0 + ai * HALF + m * 16; const float r = row_rstd(rs, row, fq);
                    float ss = 0.f;
#pragma unroll
                    for (int bj = 0; bj < 2; ++bj)
#pragma unroll
                        for (int n = 0; n < 2; ++n) { const f32x4 x = acc[ai][bj][m][n]; ss += (x[0] * x[0] + x[1] * x[1]) + (x[2] * x[2] + x[3] * x[3]); }
                    ss += __shfl_xor(ss, 16); ss += __shfl_xor(ss, 32);
                    const float sc = r * __builtin_amdgcn_rsqf(ss * r * r * (1.f / 64.f) + 1e-6f) * hs;
                    bf16_t* rowp = O + (size_t)row * 3072 + colb;
#pragma unroll
                    for (int bj = 0; bj < 2; ++bj) { const f32x4 v0 = acc[ai][bj][m][0] * sc * gv[bj][0], v1 = acc[ai][bj][m][1] * sc * gv[bj][1];
                        u32x4 w; w.x = cvt_pk_bf16(v0[0], v0[1]); w.y = cvt_pk_bf16(v0[2], v0[3]); w.z = cvt_pk_bf16(v1[0], v1[1]); w.w = cvt_pk_bf16(v1[2], v1[3]);
                        *(u32x4*)(rowp + 32 * bj) = w; } }
        } else {
            const int col0 = u.pn * BM + wc * 32 + 8 * fq;
#pragma unroll
            for (int ai = 0; ai < 2; ++ai)
#pragma unroll
                for (int m = 0; m < 4; ++m) { const int row = row0 + ai * HALF + m * 16; const float sc = row_rstd(rs, row, fq);
                    bf16_t* rowp = O + (size_t)row * 3072 + col0;
#pragma unroll
                    for (int bj = 0; bj < 2; ++bj) { const f32x4 v0 = acc[ai][bj][m][0] * sc, v1 = acc[ai][bj][m][1] * sc;
                        u32x4 w; w.x = cvt_pk_bf16(v0[0], v0[1]); w.y = cvt_pk_bf16(v0[2], v0[3]); w.z = cvt_pk_bf16(v1[0], v1[1]); w.w = cvt_pk_bf16(v1[2], v1[3]);
                        *(u32x4*)(rowp + bj * HALF) = w; } }
        }
    }
};
template <bool BASE_BF16>
struct EpiResid {
    static constexpr bool PERM = false, AFTER_DRAIN = false;
    const void* base; float* out; bf16_t* xb; float* rowss;
    __device__ __forceinline__ void operator()(const f32x4 (&acc)[2][2][4][2], const Unit& u, int wr, int wc, int fr, int fq) const {
        const int row0 = u.pm * BM + wr * 64 + fr, col0 = u.pn * BM + wc * 32 + 4 * fq;
#pragma unroll
        for (int ai = 0; ai < 2; ++ai)
#pragma unroll
            for (int m = 0; m < 4; ++m) { const int row = row0 + ai * HALF + m * 16;
                float* op = out ? out + (size_t)((!PROBE_DRY || xb || out == base) ? row : (row & 4095)) * 1024 : nullptr; bf16_t* xp = xb ? xb + (size_t)row * 1024 : nullptr;
                float ss = 0.f;
#pragma unroll
                for (int bj = 0; bj < 2; ++bj)
#pragma unroll
                    for (int n = 0; n < 2; ++n) { const int col = col0 + bj * HALF + n * 16;
                        f32x4 b;
                        if (BASE_BF16) { const u32x2 w = *(const u32x2*)((const bf16_t*)base + (size_t)row * 1024 + col);
                            b[0] = __builtin_bit_cast(float, w.x << 16); b[1] = __builtin_bit_cast(float, w.x & 0xffff0000u); b[2] = __builtin_bit_cast(float, w.y << 16); b[3] = __builtin_bit_cast(float, w.y & 0xffff0000u); }
                        else b = *(const f32x4*)((const float*)base + (size_t)row * 1024 + col);
                        const f32x4 o = b + acc[ai][bj][m][n];
                        if (out) *(f32x4*)(op + col) = o;
                        if (xb) { u32x2 w; w.x = cvt_pk_bf16(o[0], o[1]); w.y = cvt_pk_bf16(o[2], o[3]); *(u32x2*)(xp + col) = w;
                            ss += (o[0] * o[0] + o[1] * o[1]) + (o[2] * o[2] + o[3] * o[3]); } }
                if (xb) { ss += __shfl_xor(ss, 16); ss += __shfl_xor(ss, 32); if (fq == 0) rowss[(size_t)row * 16 + u.pn * 4 + wc] = ss; } }
    }
};
template <int CTRL> __device__ __forceinline__ float dppf(float old, float src) {
    return __builtin_bit_cast(float, __builtin_amdgcn_update_dpp(__builtin_bit_cast(int, old), __builtin_bit_cast(int, src), CTRL, 0xF, 0xF, false));
}
struct EpiConv {
    static constexpr bool PERM = false, AFTER_DRAIN = false;
    bf16_t* G;
    float* UH;
    const float* cw;
    const float* cb;
    const float* rs;
    __device__ __forceinline__ void operator()(const f32x4 (&acc)[2][2][4][2], const Unit& u, int wr, int wc, int fr, int fq) const {
        const float NL2E = -1.4426950408889634f;
        float rsc[2][4];
#pragma unroll
        for (int ai = 0; ai < 2; ++ai)
#pragma unroll
            for (int m = 0; m < 4; ++m) rsc[ai][m] = row_rstd(rs, u.pm * BM + ai * HALF + wr * 64 + m * 16 + fr, fq);
#pragma unroll
        for (int n = 0; n < 2; ++n) {
            const int f = u.pn * 128 + wc * 32 + n * 16 + 4 * fq;
            const f32x4 wg0 = *(const f32x4*)(cw + f), wg1 = *(const f32x4*)(cw + 5632 + f), wg2 = *(const f32x4*)(cw + 11264 + f), bg = *(const f32x4*)(cb + f);
            const f32x4 wv0 = *(const f32x4*)(cw + 2816 + f), wv1 = *(const f32x4*)(cw + 5632 + 2816 + f), wv2 = *(const f32x4*)(cw + 11264 + 2816 + f), bv = *(const f32x4*)(cb + 2816 + f);
#pragma unroll
            for (int ai = 0; ai < 2; ++ai) {
                const int blk = u.pm * 4 + ai * 2 + wr, rowb = blk * 64;
                if (rowb < NVALID) {
#pragma unroll
                    for (int m = 0; m < 4; ++m) {
                        const int row = rowb + m * 16 + fr;
                        const f32x4 cg = acc[ai][0][m][n] * rsc[ai][m], cv = acc[ai][1][m][n] * rsc[ai][m];
                        f32x4 g1, g2, v1, v2;
#pragma unroll
                        for (int e = 0; e < 4; ++e) {
                            float og1 = 0.f, og2 = 0.f, ov1 = 0.f, ov2 = 0.f;
                            if (m > 0) { const float pg = acc[ai][0][m > 0 ? m - 1 : 0][n][e] * rsc[ai][m > 0 ? m - 1 : 0], pv = acc[ai][1][m > 0 ? m - 1 : 0][n][e] * rsc[ai][m > 0 ? m - 1 : 0];
                                og1 = dppf<0x10F>(0.f, pg); og2 = dppf<0x10E>(0.f, pg); ov1 = dppf<0x10F>(0.f, pv); ov2 = dppf<0x10E>(0.f, pv); }
                            g1[e] = dppf<0x111>(og1, cg[e]); g2[e] = dppf<0x112>(og2, cg[e]);
                            v1[e] = dppf<0x111>(ov1, cv[e]); v2[e] = dppf<0x112>(ov2, cv[e]);
                        }
                        const f32x4 xg = bg + wg0 * g2 + wg1 * g1 + wg2 * cg, xv = bv + wv0 * v2 + wv1 * v1 + wv2 * cv;
                        f32x4 o;
#pragma unroll
                        for (int e = 0; e < 4; ++e) { const float s = __builtin_amdgcn_rcpf(1.f + __builtin_amdgcn_exp2f(xg[e] * NL2E)); o[e] = xg[e] * s * xv[e]; }
                        if (row < NVALID && (m > 0 || fr >= 2)) { u32x2 w; w.x = cvt_pk_bf16(o[0], o[1]); w.y = cvt_pk_bf16(o[2], o[3]); *(u32x2*)(G + (size_t)row * 2816 + f) = w; }
                        if (m == 0 && fr < 2) { float* p = UH + (size_t)(blk * 4 + fr) * 5632 + f; *(f32x4*)p = cg; *(f32x4*)(p + 2816) = cv; }
                        if (m == 3 && fr >= 14) { float* p = UH + (size_t)(blk * 4 + 2 + (fr - 14)) * 5632 + f; *(f32x4*)p = cg; *(f32x4*)(p + 2816) = cv; }
                    }
                }
            }
        }
    }
};
template <class Epi, class Sched, bool ALIGN_EPI = false, bool SP2 = false>
__device__ __forceinline__ void gemm_phase(PG8_LAS unsigned char* lds, const Gemm g, const Sched& S, const Epi& E) {
    int tid_l = threadIdx.x; asm volatile("" : "+v"(tid_l));
    const int tid = tid_l, wid = __builtin_amdgcn_readfirstlane(tid >> 6), lane = tid & 63, wr = wid >> 2, wc = wid & 3, fr = lane & 15, fq = lane >> 4;
    const int K = g.K, nt = K / BK;
    unsigned voffA[2], voffB[2];
#pragma unroll
    for (int i = 0; i < 2; ++i) { int R, C; stage_rc(tid * 16 + i * 8192, R, C); const int Rb = Epi::PERM ? ((R & ~31) + perm32(R & 31)) : R;
        voffA[i] = (unsigned)(R * K + C) * 2u; voffB[i] = (unsigned)(Rb * K + C) * 2u; }
    const size_t kstep = (size_t)(BK * 2);
    const size_t hstep = (size_t)HALF * K * 2;
    const size_t tstep = 2 * hstep;
    const unsigned ldsw = (unsigned)wid * 1024u;
    const int aoff = lds_byte(wr * 64 + fr, fq * 8), boff = lds_byte(wc * 32 + fr, fq * 8);
#define PG8_SA(b, h) (((b) * 2 + (h)) * HTB)
#define PG8_SB(b, h) ((4 + (b) * 2 + (h)) * HTB)
#define PG8_STAGE(bufoff, gbase, voff) do { _Pragma("unroll") for (int _i = 0; _i < 2; ++_i) \
        __builtin_amdgcn_global_load_lds((const unsigned*)((const char*)(gbase) + (voff)[_i]), (PG8_LAS unsigned*)(lds + (bufoff) + ldsw + _i * 8192), 16, 0, 0); } while (0)
#define PG8_LDA(dst, b, h) do { _Pragma("unroll") for (int m = 0; m < 4; ++m) _Pragma("unroll") for (int k = 0; k < 2; ++k) dst[m][k] = *(const PG8_LAS bf16x8*)(lds + PG8_SA(b, h) + aoff + m * 2048 + k * 1024); } while (0)
#define PG8_LDB(dst, b, h) do { _Pragma("unroll") for (int n = 0; n < 2; ++n) _Pragma("unroll") for (int k = 0; k < 2; ++k) dst[n][k] = *(const PG8_LAS bf16x8*)(lds + PG8_SB(b, h) + boff + n * 2048 + k * 1024); } while (0)
#define PG8_MMA(ai, bj, At, Bt) do { __builtin_amdgcn_s_setprio(1); _Pragma("unroll") for (int m = 0; m < 4; ++m) _Pragma("unroll") for (int n = 0; n < 2; ++n) _Pragma("unroll") for (int k = 0; k < 2; ++k) \
        acc[ai][bj][m][n] = __builtin_amdgcn_mfma_f32_16x16x32_bf16(Bt[n][k], At[m][k], acc[ai][bj][m][n], 0, 0, 0); __builtin_amdgcn_s_setprio(0); } while (0)
#define PG8_WAIT_V(n) asm volatile("s_waitcnt vmcnt(" #n ")" ::: "memory")
#define PG8_WAIT_L(n) asm volatile("s_waitcnt lgkmcnt(" #n ")" ::: "memory")
#define PG8_BAR __builtin_amdgcn_s_barrier()
#define PG8_SCHED __builtin_amdgcn_sched_barrier(0)
    Unit cur, nxt; int ui = 0;
    if (!S.next(0, cur)) return;
    f32x4 acc[2][2][4][2];
#pragma unroll
    for (int a = 0; a < 2; ++a)
#pragma unroll
        for (int b = 0; b < 2; ++b)
#pragma unroll
            for (int m = 0; m < 4; ++m)
#pragma unroll
                for (int n = 0; n < 2; ++n) acc[a][b][m][n] = (f32x4){0.f, 0.f, 0.f, 0.f};
    bf16x8 At[4][2], B0[2][2], B1[2][2];
    const char* cA = (const char*)g.A + (size_t)cur.pm * tstep; const char* cB = (const char*)g.Bt + (size_t)cur.pn * tstep;
    S.a_ready(cur);
    if constexpr (SP2) {
        PG8_STAGE(PG8_SB(0, 0), cB, voffB); PG8_STAGE(PG8_SB(0, 1), cB + hstep, voffB); PG8_STAGE(PG8_SA(0, 0), cA, voffA); PG8_STAGE(PG8_SA(0, 1), cA + hstep, voffA);
        if (wr == 1) PG8_BAR;
        PG8_WAIT_V(2); PG8_BAR;
        PG8_STAGE(PG8_SB(1, 0), cB + kstep, voffB); PG8_STAGE(PG8_SA(1, 0), cA + kstep, voffA); PG8_STAGE(PG8_SB(1, 1), cB + hstep + kstep, voffB);
        PG8_WAIT_V(6); PG8_BAR;
    } else {
        PG8_STAGE(PG8_SB(0, 0), cB, voffB); PG8_STAGE(PG8_SA(0, 0), cA, voffA); PG8_STAGE(PG8_SB(0, 1), cB + hstep, voffB); PG8_STAGE(PG8_SA(0, 1), cA + hstep, voffA);
        if (wr == 1) PG8_BAR;
        PG8_WAIT_V(4); PG8_BAR;
        PG8_STAGE(PG8_SB(1, 0), cB + kstep, voffB); PG8_STAGE(PG8_SA(1, 0), cA + kstep, voffA); PG8_STAGE(PG8_SB(1, 1), cB + hstep + kstep, voffB);
        PG8_WAIT_V(6); PG8_BAR;
    }
    for (;;) {
        const bool has_next = S.next(ui + 1, nxt);
        const char* nA = has_next ? (const char*)g.A + (size_t)nxt.pm * tstep : cA; const char* nB = has_next ? (const char*)g.Bt + (size_t)nxt.pn * tstep : cB;
        for (int t = 0; t < nt; t += 2) {
            const bool last = (t == nt - 2);
            const char* a1 = cA + (size_t)(t + 1) * kstep;
            const char* a2 = last ? nA : cA + (size_t)(t + 2) * kstep; const char* b2 = last ? nB : cB + (size_t)(t + 2) * kstep;
            const char* a3 = a2 + kstep; const char* b3 = b2 + kstep;
            if (last && has_next) S.a_ready(nxt);
            if constexpr (SP2) {
            PG8_LDB(B0, 0, 0); PG8_LDB(B1, 0, 1); PG8_SCHED; PG8_LDA(At, 0, 0); PG8_STAGE(PG8_SA(1, 1), a1 + hstep, voffA);
            PG8_WAIT_V(8); PG8_WAIT_L(0); PG8_BAR; PG8_MMA(0, 0, At, B0); PG8_MMA(0, 1, At, B1); PG8_BAR; PG8_SCHED;
            PG8_LDA(At, 0, 1); PG8_STAGE(PG8_SB(0, 0), b2, voffB); PG8_STAGE(PG8_SB(0, 1), b2 + hstep, voffB); PG8_STAGE(PG8_SA(0, 0), a2, voffA);
            PG8_WAIT_V(8); PG8_WAIT_L(0); PG8_BAR; PG8_MMA(1, 0, At, B0); PG8_MMA(1, 1, At, B1); PG8_BAR; PG8_SCHED;
            PG8_LDB(B0, 1, 0); PG8_LDB(B1, 1, 1); PG8_SCHED; PG8_LDA(At, 1, 0); PG8_STAGE(PG8_SA(0, 1), a2 + hstep, voffA);
            PG8_WAIT_V(8); PG8_WAIT_L(0); PG8_BAR; PG8_MMA(0, 0, At, B0); PG8_MMA(0, 1, At, B1); PG8_BAR; PG8_SCHED;
            PG8_LDA(At, 1, 1); PG8_STAGE(PG8_SB(1, 0), b3, voffB); PG8_STAGE(PG8_SB(1, 1), b3 + hstep, voffB); PG8_STAGE(PG8_SA(1, 0), a3, voffA);
            PG8_WAIT_V(8); PG8_WAIT_L(0); PG8_BAR; PG8_MMA(1, 0, At, B0); PG8_MMA(1, 1, At, B1); PG8_BAR; PG8_SCHED;
            } else {
            PG8_LDB(B0, 0, 0); PG8_SCHED; PG8_LDA(At, 0, 0); PG8_STAGE(PG8_SA(1, 1), a1 + hstep, voffA);
            PG8_WAIT_L(8); PG8_BAR; PG8_WAIT_L(0); PG8_MMA(0, 0, At, B0); PG8_BAR; PG8_SCHED;
            PG8_LDB(B1, 0, 1); PG8_STAGE(PG8_SB(0, 0), b2, voffB);
            PG8_BAR; PG8_WAIT_L(0); PG8_MMA(0, 1, At, B1); PG8_BAR;
            PG8_LDA(At, 0, 1); PG8_STAGE(PG8_SA(0, 0), a2, voffA);
            PG8_BAR; PG8_WAIT_L(0); PG8_MMA(1, 0, At, B0); PG8_BAR; PG8_SCHED;
            PG8_STAGE(PG8_SB(0, 1), b2 + hstep, voffB);
            PG8_WAIT_V(6); PG8_BAR; PG8_MMA(1, 1, At, B1); PG8_BAR;
            PG8_LDB(B0, 1, 0); PG8_SCHED; PG8_LDA(At, 1, 0); PG8_STAGE(PG8_SA(0, 1), a2 + hstep, voffA);
            PG8_WAIT_L(8); PG8_BAR; PG8_WAIT_L(0); PG8_MMA(0, 0, At, B0); PG8_BAR; PG8_SCHED;
            PG8_LDB(B1, 1, 1); PG8_STAGE(PG8_SB(1, 0), b3, voffB);
            PG8_BAR; PG8_WAIT_L(0); PG8_MMA(0, 1, At, B1); PG8_BAR;
            PG8_LDA(At, 1, 1); PG8_STAGE(PG8_SA(1, 0), a3, voffA);
            PG8_BAR; PG8_WAIT_L(0); PG8_MMA(1, 0, At, B0); PG8_BAR; PG8_SCHED;
            PG8_STAGE(PG8_SB(1, 1), b3 + hstep, voffB);
            PG8_WAIT_V(6); PG8_BAR; PG8_MMA(1, 1, At, B1); PG8_BAR;
            }
        }
        if constexpr (ALIGN_EPI) { if (wr == 0) PG8_BAR; }
        if constexpr (!Epi::AFTER_DRAIN) { E(acc, cur, wr, wc, fr, fq); S.done(cur); }
        if (!has_next) break;
#pragma unroll
        for (int a = 0; a < 2; ++a)
#pragma unroll
            for (int b = 0; b < 2; ++b)
#pragma unroll
                for (int m = 0; m < 4; ++m)
#pragma unroll
                    for (int n = 0; n < 2; ++n) acc[a][b][m][n] = (f32x4){0.f, 0.f, 0.f, 0.f};
        cur = nxt; cA = nA; cB = nB; ++ui;
        if constexpr (ALIGN_EPI) { if (wr == 1) PG8_BAR; }
    }
    PG8_WAIT_V(0);
    if constexpr (!ALIGN_EPI) { if (wr == 0) PG8_BAR; }
    PG8_BAR;
    if constexpr (Epi::AFTER_DRAIN) { E.fused(acc, cur, wr, wc, fr, fq, lds, wid, lane); S.done(cur); }
#undef PG8_SA
#undef PG8_SB
#undef PG8_STAGE
#undef PG8_LDA
#undef PG8_LDB
#undef PG8_MMA
#undef PG8_WAIT_V
#undef PG8_WAIT_L
#undef PG8_BAR
#undef PG8_SCHED
}
}

#ifndef PG8_SP2
#define PG8_SP2 true
#endif
#ifndef PG8_ALIGN
#define PG8_ALIGN true
#endif
#ifndef MK_N_LAUNCHES
#define MK_N_LAUNCHES 1
#endif
constexpr int NWAVES = 8;
constexpr int NREAL = 16384, NVALID = 16400, MROWS = 16640;
constexpr int DM = 1024, DFF = 2816, SEQ = 2048, NB = 8;
constexpr int PROJ_LD = 2120;
constexpr int KVQ_LD = 3072;
constexpr int MASKW = 34;
constexpr float EPS = 1e-6f, L2E = 1.4426950408889634f;
constexpr int BT_N = 288, BT_OFF = 224;
constexpr long SC_BATCH = 2195456;

constexpr size_t MiB = 1u << 20;
constexpr size_t WS_CTL = 0, CTL_ZERO_BYTES = 1 * MiB;
constexpr size_t WS_BT = 1 * MiB, WS_LAM = 1 * MiB + 16384, WS_HMETA = 1 * MiB + 65536;
constexpr size_t WS_WIN = 2 * MiB, WS_WOA = WS_WIN + 9 * MiB / 2, WS_WUP0 = WS_WOA + 2 * MiB, WS_WDN0 = WS_WUP0 + 11 * MiB, WS_WKVQ = WS_WDN0 + 11 * MiB / 2,
                 WS_WOB = WS_WKVQ + 6 * MiB, WS_WUP1 = WS_WOB + 2 * MiB, WS_WDN1 = WS_WUP1 + 11 * MiB, WS_WEND = WS_WDN1 + 11 * MiB / 2;
constexpr size_t WS_X0 = 50 * MiB, WS_X1 = WS_X0 + 65 * MiB / 2, WS_R = 115 * MiB;
constexpr size_t WS_PROJ = WS_R, WS_SC = WS_R + 135 * MiB / 2, WS_MASK = WS_R + 269 * MiB / 2;
constexpr size_t WS_G = WS_R, WS_UH = WS_R + 90 * MiB, WS_KVQ = WS_R;
constexpr size_t WS_END = 256 * MiB;
static_assert(WS_WEND <= WS_X0 && WS_X1 + (size_t)MROWS * DM * 2 <= WS_R, "ws map 1");
static_assert(WS_PROJ + (size_t)MROWS * PROJ_LD * 2 <= WS_SC && WS_SC + (size_t)NB * SC_BATCH * 4 <= WS_MASK && WS_MASK + (size_t)NVALID * MASKW * 8 <= WS_END, "ws map 2");
static_assert(WS_G + (size_t)MROWS * DFF * 2 <= WS_UH && WS_UH + (size_t)260 * 4 * 5632 * 4 <= WS_END && WS_KVQ + (size_t)MROWS * KVQ_LD * 2 <= WS_END, "ws map 3");
constexpr int CW_BAR = 4096;
constexpr int CW_Q0 = 64, CW_Q1 = 128;
constexpr size_t WS_PS = 230 * MiB, WS_PSM = 233 * MiB;

constexpr int RING_BYTES = 131072;
constexpr int LDS_BYTES = 163840;
constexpr int LDSCTL_OFF = LDS_BYTES - 1024, MISC_OFF = LDSCTL_OFF + 320;
constexpr int SHM_K = 16384, SHM_V = 16384;
constexpr int ALDS_V = 0, ALDS_K = 2 * SHM_V, ALDS_WS = 2 * SHM_V + 2 * SHM_K, ALDS_BT = ALDS_WS + NWAVES * 64 * 4;
static_assert(ALDS_BT + 8 * BT_N * 4 <= RING_BYTES, "attention LDS");

#define GAS __attribute__((address_space(1)))
#define LAS __attribute__((address_space(3)))
typedef unsigned short bf16;
typedef unsigned v4u __attribute__((ext_vector_type(4)));
typedef unsigned v2u __attribute__((ext_vector_type(2)));
typedef float f32x4 __attribute__((ext_vector_type(4)));
typedef float f32x16 __attribute__((ext_vector_type(16)));
typedef short bf16x8 __attribute__((ext_vector_type(8)));
typedef short s16x4 __attribute__((ext_vector_type(4)));
typedef GAS unsigned gu32;
#define RLX_AGENT __ATOMIC_RELAXED, __HIP_MEMORY_SCOPE_AGENT
#define LDS_WAIT() asm volatile("s_waitcnt lgkmcnt(0)" ::: "memory")
__device__ __forceinline__ unsigned f2bf(float f) { unsigned u = __builtin_bit_cast(unsigned, f); return (u + 0x7fffu + ((u >> 16) & 1u)) >> 16; }
__device__ __forceinline__ unsigned pk2(float lo, float hi) { return f2bf(lo) | (f2bf(hi) << 16); }
__device__ __forceinline__ float bf2f(unsigned short h) { return __builtin_bit_cast(float, (unsigned)h << 16); }
__device__ __forceinline__ unsigned cvtpk(float lo, float hi) { unsigned r; asm volatile("s_nop 0\n\tv_cvt_pk_bf16_f32 %0, %1, %2" : "=v"(r) : "v"(lo), "v"(hi)); return r; }
#define XB_TMO      128
#define XB_XCNT(j)  (256  + 64 * (j))
#define XB_XSUB(j)  (1280 + 64 * (j))
#define XB_XGEN(j)  (2304 + 64 * (j))
#define XB_TOP      3328
#define XB_TOPGEN   3392
#define XCD_BAR_WORDS 3456
#define XB_SPIN_CAP (1u << 18)

__device__ __forceinline__ unsigned xb_ld(unsigned* p)              { return __hip_atomic_load(p, __ATOMIC_RELAXED, __HIP_MEMORY_SCOPE_AGENT); }
__device__ __forceinline__ unsigned xb_add(unsigned* p, unsigned v) { return __hip_atomic_fetch_add(p, v, __ATOMIC_RELAXED, __HIP_MEMORY_SCOPE_AGENT); }
__device__ __forceinline__ unsigned xb_xcc_id() { return (unsigned)__builtin_amdgcn_s_getreg((3 << 11) | 20) & 0xFu; }
#define XB_SPIN(cond, bar) do { unsigned _sp = 0; while (cond) { __builtin_amdgcn_s_sleep(1); \
    if ((++_sp & 255u) == 0u) { if (xb_ld(&(bar)[XB_TMO])) break; if (_sp > XB_SPIN_CAP) { atomicAdd(&(bar)[XB_TMO], 1u); break; } } } } while (0)

struct XcdBarrier {
    unsigned* bar; unsigned x;
    volatile LAS unsigned* st;
};

__device__ __forceinline__ XcdBarrier xcd_barrier_post(unsigned* bar, volatile LAS unsigned* st) {
    XcdBarrier b; b.bar = bar; b.x = xb_xcc_id(); b.st = st;
    if (threadIdx.x == 0) (void)xb_add(&bar[XB_XCNT(b.x)], 1u);
    return b;
}
__device__ __forceinline__ void xcd_barrier_complete(unsigned* bar, unsigned x, unsigned& nloc, unsigned& nx) {
    const unsigned G = gridDim.x * gridDim.y * gridDim.z;
    unsigned sum, cnt, mine, sp = 0u;
    for (;;) {
        sum = 0u; cnt = 0u; mine = 0u;
#pragma unroll
        for (unsigned j = 0; j < 16; ++j) { const unsigned c = xb_ld(&bar[XB_XCNT(j)]); sum += c; cnt += (c > 0u) ? 1u : 0u; mine = (j == x) ? c : mine; }
        if (sum == G) break;
        __builtin_amdgcn_s_sleep(1);
        if ((++sp & 255u) == 0u) { if (xb_ld(&bar[XB_TMO])) break; if (sp > XB_SPIN_CAP) { atomicAdd(&bar[XB_TMO], 1u); break; } }
    }
    nloc = mine > 0u ? mine : 1u; nx = cnt > 0u ? cnt : 1u;
}

__device__ __forceinline__ void xcd_barrier(const XcdBarrier& b) {
    asm volatile("s_waitcnt vmcnt(0)" ::: "memory");
    __syncthreads();
    if (threadIdx.x == 0) {
        unsigned* bar = b.bar;
        __builtin_amdgcn_s_waitcnt(0);
        unsigned nloc = b.st[0], nx = b.st[1];
        if (nloc == 0u) { xcd_barrier_complete(bar, b.x, nloc, nx); b.st[0] = nloc; b.st[1] = nx; }
        const unsigned old = xb_add(&bar[XB_XSUB(b.x)], 1u);
        const unsigned gen = old / nloc;
        if (old + 1u == (gen + 1u) * nloc) {
            __builtin_amdgcn_fence(__ATOMIC_RELEASE, "agent");
            asm volatile("s_waitcnt vmcnt(0)" ::: "memory");
            const unsigned og = xb_add(&bar[XB_TOP], 1u);
            const unsigned tg = og / nx;
            if (og + 1u == (tg + 1u) * nx) xb_add(&bar[XB_TOPGEN], 1u);
            else XB_SPIN(xb_ld(&bar[XB_TOPGEN]) == tg, bar);
            __builtin_amdgcn_fence(__ATOMIC_ACQUIRE, "agent");
            xb_add(&bar[XB_XGEN(b.x)], 1u);
            asm volatile("s_waitcnt vmcnt(0)" ::: "memory");
        } else {
            XB_SPIN(xb_ld(&bar[XB_XGEN(b.x)]) == gen, bar);
            __builtin_amdgcn_fence(__ATOMIC_ACQUIRE, "agent");
            asm volatile("s_waitcnt vmcnt(0)" ::: "memory");
        }
    }
    __syncthreads();
}

struct Params {
    const float *x, *meta, *rel_table, *ln_attn_g, *ln_ffn_g, *w_in_a, *w_o_a, *qn_a, *kn_a, *kv_norm_g, *w_kv_b, *kn_b, *w_q_b, *qn_b,
                *lam_q1, *lam_k1, *lam_q2, *lam_k2, *subln_b, *w_o_b, *w_up, *conv_w, *conv_b, *w_down;
    float* out; unsigned char* ws; int ph_lo, ph_hi;
};
struct Frame {
    LAS unsigned char* lds;
    volatile LAS unsigned* MISC;
    gu32* ctl;
    int tid, lane, wave, G;
};
__device__ __forceinline__ float wave_sum(float v) {
#pragma unroll
    for (int o = 1; o < 64; o <<= 1) v += __shfl_xor(v, o);
    return v;
}
__device__ __forceinline__ int drow(int mode, int n) {
    if (mode == 1) { const int v = n >= DFF ? 1 : 0, f = n - v * DFF; return 256 * (f >> 7) + 128 * v + (f & 127); }
    if (mode == 2 || (mode == 3 && n < 1024)) { const int m = n >> 9, h = (n >> 6) & 7, d = n & 63, vh = 2 * h + m; return (mode == 3 ? 1024 : 0) + 256 * (vh >> 2) + 128 * (d >> 5) + 32 * (vh & 3) + (d & 31); }
    if (mode == 3) return 1024 + n;
    return n;
}
constexpr int TR_SCR = 2 * 64 * 33 * 4 + 512;
__device__ __forceinline__ void p0_transpose_item(const float* W, int K, int N, bf16* WT, const float* gain, int mode, LAS float* scr, int item, int lane) {
    const int nblk = (N + 63) / 64, kb = item / nblk, nb = item % nblk, k0 = 64 * kb, n0 = 64 * nb;
    const int c4 = 4 * (lane & 7), kq = lane >> 3;
    f32x4 v[2][8];
#pragma unroll
    for (int h = 0; h < 2; ++h) { const bool nok = n0 + 32 * h + c4 < N;
#pragma unroll
        for (int i = 0; i < 8; ++i) { const int kk = kq + 8 * i; v[h][i] = (f32x4){0.f, 0.f, 0.f, 0.f}; if (nok) v[h][i] = *(const f32x4*)(W + (size_t)(k0 + kk) * N + n0 + 32 * h + c4); } }
#pragma unroll
    for (int h = 0; h < 2; ++h)
#pragma unroll
        for (int i = 0; i < 8; ++i) { const int kk = kq + 8 * i; const float g = gain ? gain[k0 + kk] : 1.f; LAS float* d = scr + h * (64 * 33) + kk * 33 + c4; d[0] = v[h][i][0] * g; d[1] = v[h][i][1] * g; d[2] = v[h][i][2] * g; d[3] = v[h][i][3] * g; }
    LDS_WAIT(); asm volatile("" ::: "memory");
    const int c = lane & 7;
#pragma unroll
    for (int h = 0; h < 2; ++h)
#pragma unroll
        for (int j = 0; j < 4; ++j) { const int n = (lane >> 3) + 8 * j; const LAS float* sp = scr + h * (64 * 33) + (8 * c) * 33 + n;
            v4u o; o.x = pk2(sp[0 * 33], sp[1 * 33]); o.y = pk2(sp[2 * 33], sp[3 * 33]); o.z = pk2(sp[4 * 33], sp[5 * 33]); o.w = pk2(sp[6 * 33], sp[7 * 33]);
            if (n0 + 32 * h + n < N) *(GAS v4u*)(WT + (size_t)drow(mode, n0 + 32 * h + n) * K + k0 + 8 * c) = o; }
    LDS_WAIT(); asm volatile("" ::: "memory");
}
__device__ __forceinline__ int rel_bucket(int rel) {
    const int n = rel < 0 ? -rel : rel;
    int b = n < 8 ? n : n < 12 ? 8 : n < 16 ? 9 : n < 23 ? 10 : n < 32 ? 11 : n < 46 ? 12 : n < 64 ? 13 : n < 91 ? 14 : 15;
    return b + (rel > 0 ? 16 : 0);
}
__device__ __forceinline__ void norm_row_to_bf16(const float* xrow, bf16* orow, int lane) {
    const GAS f32x4* xr = (const GAS f32x4*)xrow + lane;
    f32x4 v[4]; float s = 0.f;
#pragma unroll
    for (int j = 0; j < 4; ++j) { v[j] = xr[64 * j]; s += (v[j].x * v[j].x + v[j].y * v[j].y) + (v[j].z * v[j].z + v[j].w * v[j].w); }
    const float rstd = 1.f / sqrtf(wave_sum(s) * (1.f / DM) + EPS);
    GAS unsigned long long* o8 = (GAS unsigned long long*)orow + lane;
#pragma unroll
    for (int j = 0; j < 4; ++j) o8[64 * j] = (unsigned long long)pk2(v[j].x * rstd, v[j].y * rstd) | ((unsigned long long)pk2(v[j].z * rstd, v[j].w * rstd) << 32);
}
__device__ __forceinline__ void norm_phase(Frame& F, const float* src_real, const float* src_meta, bf16* dst) {
    const int gw = blockIdx.x * NWAVES + F.wave, NGW = F.G * NWAVES;
    for (int r = gw; r < NVALID; r += 2 * NGW) {
        const int r2 = r + NGW; const bool has2 = r2 < NVALID; const int rb = has2 ? r2 : r;
        const float* sa = r < NREAL ? src_real + (size_t)r * DM : src_meta + (size_t)(r - NREAL) * DM;
        const float* sb = rb < NREAL ? src_real + (size_t)rb * DM : src_meta + (size_t)(rb - NREAL) * DM;
        const GAS f32x4* xa = (const GAS f32x4*)sa + F.lane; const GAS f32x4* xb = (const GAS f32x4*)sb + F.lane;
        f32x4 va[4], vb[4]; float s0 = 0.f, s1 = 0.f;
#pragma unroll
        for (int j = 0; j < 4; ++j) { va[j] = xa[64 * j]; vb[j] = xb[64 * j]; }
#pragma unroll
        for (int j = 0; j < 4; ++j) { s0 += (va[j].x * va[j].x + va[j].y * va[j].y) + (va[j].z * va[j].z + va[j].w * va[j].w); s1 += (vb[j].x * vb[j].x + vb[j].y * vb[j].y) + (vb[j].z * vb[j].z + vb[j].w * vb[j].w); }
        const float ra = 1.f / sqrtf(wave_sum(s0) * (1.f / DM) + EPS), rbs = 1.f / sqrtf(wave_sum(s1) * (1.f / DM) + EPS);
        GAS unsigned long long* oa = (GAS unsigned long long*)(dst + (size_t)r * DM) + F.lane; GAS unsigned long long* ob = (GAS unsigned long long*)(dst + (size_t)rb * DM) + F.lane;
#pragma unroll
        for (int j = 0; j < 4; ++j) { oa[64 * j] = (unsigned long long)pk2(va[j].x * ra, va[j].y * ra) | ((unsigned long long)pk2(va[j].z * ra, va[j].w * ra) << 32);
            if (has2) ob[64 * j] = (unsigned long long)pk2(vb[j].x * rbs, vb[j].y * rbs) | ((unsigned long long)pk2(vb[j].z * rbs, vb[j].w * rbs) << 32); }
    }
}
__device__ __forceinline__ void convert_l1_weights(Frame& F, const Params& P, int gw, int NGW) {
    LAS float* scr = (LAS float*)(F.lds + F.wave * TR_SCR);
    unsigned char* ws = P.ws;
    constexpr int I_O = 16 * 16, I_UP = 16 * 88, I_DN = 44 * 16, I_Q = 16 * 16, I_KV = 16 * 32;
    constexpr int NITEMS = I_DN + I_Q + I_KV + I_O + I_UP + I_DN;
    for (int it = gw; it < NITEMS; it += NGW) {
        int r = it;
        if (r < I_DN) { p0_transpose_item(P.w_down, DFF, DM, (bf16*)(ws + WS_WDN0), nullptr, 0, scr, r, F.lane); continue; } r -= I_DN;
        if (r < I_Q)  { p0_transpose_item(P.w_q_b, DM, DM, (bf16*)(ws + WS_WKVQ), P.ln_attn_g + DM, 2, scr, r, F.lane); continue; } r -= I_Q;
        if (r < I_KV) { p0_transpose_item(P.w_kv_b, DM, 2048, (bf16*)(ws + WS_WKVQ), P.kv_norm_g, 3, scr, r, F.lane); continue; } r -= I_KV;
        if (r < I_O)  { p0_transpose_item(P.w_o_b, DM, DM, (bf16*)(ws + WS_WOB), nullptr, 0, scr, r, F.lane); continue; } r -= I_O;
        if (r < I_UP) { p0_transpose_item(P.w_up + (size_t)DM * 2 * DFF, DM, 2 * DFF, (bf16*)(ws + WS_WUP1), P.ln_ffn_g + DM, 1, scr, r, F.lane); continue; } r -= I_UP;
        p0_transpose_item(P.w_down + (size_t)DFF * DM, DFF, DM, (bf16*)(ws + WS_WDN1), nullptr, 0, scr, r, F.lane);
    }
}
__device__ __forceinline__ void p0_prologue(Frame& F, const Params& P) {
    LAS float* scr = (LAS float*)(F.lds + F.wave * TR_SCR);
    unsigned char* ws = P.ws;
    const int gw = blockIdx.x * NWAVES + F.wave, NGW = F.G * NWAVES;
    constexpr int I_IN = 16 * 34, I_O = 16 * 16, I_UP = 16 * 88;
    constexpr int NITEMS = I_IN + I_O + I_UP;
    for (int it = gw; it < NITEMS; it += NGW) {
        int r = it;
        if (r < I_IN) { p0_transpose_item(P.w_in_a, DM, 2120, (bf16*)(ws + WS_WIN), P.ln_attn_g, 0, scr, r, F.lane); continue; } r -= I_IN;
        if (r < I_O)  { p0_transpose_item(P.w_o_a, DM, DM, (bf16*)(ws + WS_WOA), nullptr, 0, scr, r, F.lane); continue; } r -= I_O;
        p0_transpose_item(P.w_up, DM, 2 * DFF, (bf16*)(ws + WS_WUP0), P.ln_ffn_g, 1, scr, r, F.lane);
    }
    { GAS v4u* z = (GAS v4u*)(ws + WS_WIN + (size_t)2120 * DM * 2); const int nz = 184 * DM * 2 / 16;
      for (int i = blockIdx.x * NWAVES * 64 + F.tid; i < nz; i += F.G * NWAVES * 64) z[i] = (v4u){0u, 0u, 0u, 0u}; }
    if (blockIdx.x == 0) {
        float* bt = (float*)(ws + WS_BT);
        for (int i = F.tid; i < 8 * BT_N; i += NWAVES * 64) { const int h = i / BT_N, rel = i % BT_N - BT_OFF; bt[i] = P.rel_table[rel_bucket(rel) * 8 + h] * L2E; }
        if (F.wave == 0) { const float a = wave_sum(P.lam_q1[F.lane] * P.lam_k1[F.lane]), b = wave_sum(P.lam_q2[F.lane] * P.lam_k2[F.lane]);
            const float lam_init = 0.8f - 0.6f * expf(-0.3f); if (F.lane == 0) *(float*)(ws + WS_LAM) = expf(a) - expf(b) + lam_init; }
    }
    norm_phase(F, P.x, P.meta, (bf16*)(ws + WS_X0));
}
template <int HL> __device__ __forceinline__ void headnorm_phase(Frame& F, bf16* buf, int ld, int qcol, int nq, int kcol, int nk, const float* gq, const float* gk, float qscale) {
    const int gw = blockIdx.x * NWAVES + F.wave, NGW = F.G * NWAVES, nch = nq + nk;
    for (int r = gw; r < NVALID; r += NGW) {
        bf16* row = buf + (size_t)r * ld;
        for (int c0 = 0; c0 < nch; c0 += 64) {
            const int c = c0 + F.lane; const bool ok = c < nch; const int cc = ok ? c : nch - 1;
            const bool isq = cc < nq; bf16* p = row + (isq ? qcol + cc * 8 : kcol + (cc - nq) * 8);
            const v4u w = *(const GAS v4u*)p;
            float v[8]; v[0] = bf2f(w.x & 0xffff); v[1] = bf2f(w.x >> 16); v[2] = bf2f(w.y & 0xffff); v[3] = bf2f(w.y >> 16); v[4] = bf2f(w.z & 0xffff); v[5] = bf2f(w.z >> 16); v[6] = bf2f(w.w & 0xffff); v[7] = bf2f(w.w >> 16);
            float ss = 0.f;
#pragma unroll
            for (int e = 0; e < 8; ++e) ss += v[e] * v[e];
#pragma unroll
            for (int o = 1; o < HL; o <<= 1) ss += __shfl_xor(ss, o);
            const float rstd = 1.f / sqrtf(ss * (1.f / (HL * 8)) + EPS) * (isq ? qscale : 1.f);
            const float* g = (isq ? gq : gk) + ((isq ? cc : cc - nq) % HL) * 8;
            v4u o; o.x = pk2(v[0] * rstd * g[0], v[1] * rstd * g[1]); o.y = pk2(v[2] * rstd * g[2], v[3] * rstd * g[3]); o.z = pk2(v[4] * rstd * g[4], v[5] * rstd * g[5]); o.w = pk2(v[6] * rstd * g[6], v[7] * rstd * g[7]);
            if (ok) *(GAS v4u*)p = o;
        }
    }
}
constexpr int IX_ROW = 2080;
__device__ __forceinline__ unsigned key16x2(unsigned w) { const unsigned m = (w >> 15) & 0x00010001u; return w ^ (0x80008000u | (m * 0x7FFFu)); }
__device__ __forceinline__ void radix_find_pair(LAS unsigned* hist, const int (&need)[2], int (&bin)[2], int (&above)[2], int lane) {
    const v4u h4 = *(LAS v4u*)(hist + 4 * lane);
    const unsigned s = h4.x + h4.y + h4.z + h4.w; unsigned incl = s;
#pragma unroll
    for (int o = 1; o < 64; o <<= 1) { const unsigned t = (unsigned)__shfl_down((int)incl, o); incl += (lane + o < 64) ? t : 0u; }
#pragma unroll
    for (int h = 0; h < 2; ++h) {
        const int ih = (int)((incl >> (16 * h)) & 0xFFFFu), sh = (int)((s >> (16 * h)) & 0xFFFFu);
        const unsigned long long ball = __ballot(ih >= need[h]);
        const int L = 63 - __builtin_clzll(ball | 1ull);
        int cum = __builtin_amdgcn_readlane(ih, L) - __builtin_amdgcn_readlane(sh, L);
        const int c3 = __builtin_amdgcn_readlane((int)((h4.w >> (16 * h)) & 0xFFFFu), L), c2 = __builtin_amdgcn_readlane((int)((h4.z >> (16 * h)) & 0xFFFFu), L), c1 = __builtin_amdgcn_readlane((int)((h4.y >> (16 * h)) & 0xFFFFu), L);
        int b = 4 * L + 3;
        if (cum + c3 < need[h]) { cum += c3; b = 4 * L + 2; if (cum + c2 < need[h]) { cum += c2; b = 4 * L + 1; if (cum + c1 < need[h]) { cum += c1; b = 4 * L; } } }
        above[h] = cum; bin[h] = b;
    }
}
__device__ __forceinline__ void select4(const LAS unsigned short* srow, unsigned long long* mrow, int qt, LAS unsigned* hist, int lane) {
    const int nit = qt + 2;
    if (qt <= 2) { unsigned long long w = 0ull; if (lane == 0) w = 0xFFFFull; else if (lane < nit) w = ~0ull;
        if (lane < MASKW) {
#pragma unroll
            for (int r = 0; r < 4; ++r) mrow[r * MASKW + lane] = w; }
        return; }
    const int nw = (80 + 64 * qt) >> 1;
    int D0[4], D1[4], need[4] = {256, 256, 256, 256};
#pragma unroll
    for (int pass = 0; pass < 2; ++pass) {
        *(LAS v4u*)(hist + 4 * lane) = (v4u){0u, 0u, 0u, 0u}; *(LAS v4u*)(hist + 256 + 4 * lane) = (v4u){0u, 0u, 0u, 0u};
        asm volatile("s_waitcnt lgkmcnt(0)" ::: "memory");
        for (int idx = lane; idx < nw; idx += 64) {
            unsigned u[4];
#pragma unroll
            for (int r = 0; r < 4; ++r) u[r] = key16x2(((const LAS unsigned*)(srow + r * IX_ROW))[idx]);
#pragma unroll
            for (int r = 0; r < 4; ++r) { LAS unsigned* H = hist + (r >> 1) * 256; const unsigned inc = (r & 1) ? 65536u : 1u; const unsigned k0 = u[r] & 0xFFFFu, k1 = u[r] >> 16;
                if (pass == 0) { __hip_atomic_fetch_add(H + (k0 >> 8), inc, __ATOMIC_RELAXED, __HIP_MEMORY_SCOPE_WORKGROUP); __hip_atomic_fetch_add(H + (k1 >> 8), inc, __ATOMIC_RELAXED, __HIP_MEMORY_SCOPE_WORKGROUP); }
                else { if ((int)(k0 >> 8) == D0[r]) __hip_atomic_fetch_add(H + (k0 & 255u), inc, __ATOMIC_RELAXED, __HIP_MEMORY_SCOPE_WORKGROUP);
                       if ((int)(k1 >> 8) == D0[r]) __hip_atomic_fetch_add(H + (k1 & 255u), inc, __ATOMIC_RELAXED, __HIP_MEMORY_SCOPE_WORKGROUP); } }
        }
        asm volatile("s_waitcnt lgkmcnt(0)" ::: "memory");
#pragma unroll
        for (int pr = 0; pr < 2; ++pr) { const int nd[2] = {need[2 * pr], need[2 * pr + 1]}; int bn[2], ab[2];
            radix_find_pair(hist + pr * 256, nd, bn, ab, lane);
            if (pass == 0) { D0[2 * pr] = bn[0]; D0[2 * pr + 1] = bn[1]; } else { D1[2 * pr] = bn[0]; D1[2 * pr + 1] = bn[1]; }
            need[2 * pr] -= ab[0]; need[2 * pr + 1] -= ab[1]; }
        asm volatile("s_waitcnt lgkmcnt(0)" ::: "memory");
    }
    unsigned T[4]; unsigned long long myword[4] = {0ull, 0ull, 0ull, 0ull};
#pragma unroll
    for (int r = 0; r < 4; ++r) T[r] = ((unsigned)D0[r] << 8) | (unsigned)D1[r];
    const unsigned long long below = (1ull << lane) - 1ull;
    for (int i = 0; i < nit; ++i) {
        const bool ok = (i > 0) || (lane < 16); const int e = (i == 0) ? (lane & 15) : 16 + 64 * (i - 1) + lane;
        unsigned u[4];
#pragma unroll
        for (int r = 0; r < 4; ++r) u[r] = key16x2(srow[r * IX_ROW + e]) & 0xFFFFu;
#pragma unroll
        for (int r = 0; r < 4; ++r) {
            const unsigned long long gtb = __ballot(ok && u[r] > T[r]), eqb = __ballot(ok && u[r] == T[r]);
            const int ne = __popcll(eqb); unsigned long long sel = eqb;
            if (ne > need[r]) sel = __ballot(ok && (u[r] == T[r]) && (__popcll(eqb & below) < need[r]));
            need[r] -= __popcll(sel);
            if (lane == i) myword[r] = gtb | sel;
        }
    }
    if (lane < MASKW) {
#pragma unroll
        for (int r = 0; r < 4; ++r) mrow[r * MASKW + lane] = myword[r]; }
}
constexpr int IX_SROWS = 8 * 4 * IX_ROW * 2;
constexpr int IX_STG = 64 * 144;
static_assert(IX_SROWS + 2 * IX_STG <= LDSCTL_OFF && 8 * 2048 <= 2 * IX_STG, "indexer LDS");
__device__ __forceinline__ void idxsel_sub(const bf16* PROJ, unsigned long long* MASK, LAS unsigned char* lds, int b, int qt, int q0, int wave, int lane, int tid) {
    const int j = lane & 31, hi = lane >> 5;
    LAS _Float16* srow = (LAS _Float16*)(lds + wave * (4 * IX_ROW * 2)); LAS unsigned* hist = (LAS unsigned*)(lds + IX_SROWS + wave * 2048);
    LAS unsigned char* stg = lds + IX_SROWS;
    __syncthreads();
    if (qt >= 3) {
        bf16x8 af[4];
        { const bf16* ap = PROJ + (size_t)(q0 + (j >> 3)) * PROJ_LD + 1536 + (j & 7) * 64 + hi * 8;
#pragma unroll
          for (int ks = 0; ks < 4; ++ks) af[ks] = *(const bf16x8*)(ap + ks * 16); }
        float w[16];
#pragma unroll
        for (int r = 0; r < 16; ++r) w[r] = bf2f(PROJ[(size_t)(q0 + (r >> 2)) * PROJ_LD + 2112 + (r & 3) + 4 * hi]) * 0.044194173824159216f;
        const int ng = qt + 2;
        LAS _Float16* sw = srow + (2 * hi) * IX_ROW;
        const int sslot = tid >> 3, spiece = tid & 7;
        bf16x8 sreg;
#define IX_GLOAD(g_) do { const int krow_ = (g_) == 0 ? NREAL + (sslot < 16 ? sslot : 15) : b * SEQ + 64 * ((g_) - 1) + sslot; sreg = *(const bf16x8*)(PROJ + (size_t)krow_ * PROJ_LD + 2048 + spiece * 8); } while (0)
#define IX_GWRITE(buf_) do { *(LAS bf16x8*)(stg + (buf_) * IX_STG + sslot * 144 + spiece * 16) = sreg; } while (0)
#define IX_COMP(buf_, g_, blk_) do { const LAS unsigned char* bp_ = stg + (buf_) * IX_STG + (32 * (blk_) + j) * 144 + hi * 16; f32x16 acc = {}; \
            _Pragma("unroll") for (int ks = 0; ks < 4; ++ks) { const bf16x8 bf_ = *(const LAS bf16x8*)(bp_ + ks * 32); acc = __builtin_amdgcn_mfma_f32_32x32x16_bf16(af[ks], bf_, acc, 0, 0, 0); } \
            float s_[4]; _Pragma("unroll") for (int q = 0; q < 4; ++q) { float t = 0.f; _Pragma("unroll") for (int i = 0; i < 4; ++i) t += w[4 * q + i] * fmaxf(acc[4 * q + i], 0.f); \
                auto rr_ = __builtin_amdgcn_permlane32_swap(__float_as_uint(t), __float_as_uint(t), false, false); s_[q] = __uint_as_float(rr_[0]) + __uint_as_float(rr_[1]); } \
            float s0 = hi ? s_[2] : s_[0], s1 = hi ? s_[3] : s_[1]; s0 = (s0 == 0.f) ? 0.f : s0; s1 = (s1 == 0.f) ? 0.f : s1; \
            const int col = (g_) == 0 ? j : 16 + 64 * ((g_) - 1) + 32 * (blk_) + j; \
            if ((g_) > 0 || j < 16) { sw[col] = (_Float16)s0; sw[IX_ROW + col] = (_Float16)s1; } } while (0)
        IX_GLOAD(0); IX_GWRITE(0); __syncthreads();
        for (int g = 0; g < ng; g += 2) {
            if (g + 1 < ng) IX_GLOAD(g + 1);
            IX_COMP(0, g, 0); if (g > 0) IX_COMP(0, g, 1);
            if (g + 1 < ng) IX_GWRITE(1);
            __syncthreads();
            if (g + 1 < ng) {
                if (g + 2 < ng) IX_GLOAD(g + 2);
                IX_COMP(1, g + 1, 0); IX_COMP(1, g + 1, 1);
                if (g + 2 < ng) IX_GWRITE(0);
                __syncthreads();
            }
        }
#undef IX_GLOAD
#undef IX_GWRITE
#undef IX_COMP
        asm volatile("s_waitcnt lgkmcnt(0)" ::: "memory");
    }
    select4((const LAS unsigned short*)srow, MASK + (size_t)q0 * MASKW, qt, hist, lane);
}
__device__ __forceinline__ void idxsel_phase(Frame& F, const bf16* PROJ, unsigned long long* MASK) {
    if (blockIdx.x == 0 && F.tid < 16) MASK[(size_t)(NREAL + F.tid) * MASKW] = 0xFFFFull;
    for (int w = (int)blockIdx.x; w < 256; w += F.G) {
        const int b = w >> 5, p = w & 31, qt = p >> 1, half = p & 1;
        idxsel_sub(PROJ, MASK, F.lds, b, 31 - qt, b * SEQ + 64 * (31 - qt) + 32 * half + 4 * F.wave, F.wave, F.lane, F.tid);
        idxsel_sub(PROJ, MASK, F.lds, b, qt, b * SEQ + 64 * qt + 32 * half + 4 * F.wave, F.wave, F.lane, F.tid);
    }
}
__device__ __forceinline__ float meta_rstd(Frame& F, const float* psm) {
    const int row = F.tid >> 5, j = F.tid & 31; float t = 0.f;
#pragma unroll
    for (int k = 0; k < 8; ++k) t += psm[row * 256 + j + 32 * k];
#pragma unroll
    for (int o = 1; o < 32; o <<= 1) t += __shfl_xor(t, o);
    return __builtin_amdgcn_rsqf(t * (1.f / 1024.f) + 1e-6f);
}
__device__ __forceinline__ float meta_gemm(Frame& F, const bf16* A16, int lda, const bf16* Bt, int K, int b0r, int b1r) {
    const int fr = F.lane & 15, fq = F.lane >> 4, kper = K >> 3, k0 = F.wave * kper;
    const bf16* ap = A16 + (size_t)fr * lda + k0 + 8 * fq;
    const bf16* bp0 = Bt + (size_t)b0r * K + k0 + 8 * fq; const bf16* bp1 = Bt + (size_t)b1r * K + k0 + 8 * fq;
    f32x4 acc0 = {0.f, 0.f, 0.f, 0.f}, acc1 = {0.f, 0.f, 0.f, 0.f};
    for (int k = 0; k < kper; k += 32) { const bf16x8 a = *(const bf16x8*)(ap + k), b0 = *(const bf16x8*)(bp0 + k), b1 = *(const bf16x8*)(bp1 + k);
        acc0 = __builtin_amdgcn_mfma_f32_16x16x32_bf16(b0, a, acc0, 0, 0, 0); acc1 = __builtin_amdgcn_mfma_f32_16x16x32_bf16(b1, a, acc1, 0, 0, 0); }
    LAS float* part = (LAS float*)F.lds;
    LAS float* pp = part + F.wave * 512 + fr * 32 + 4 * fq;
    *(LAS f32x4*)pp = acc0; *(LAS f32x4*)(pp + 16) = acc1;
    __syncthreads();
    float v = 0.f;
#pragma unroll
    for (int w = 0; w < 8; ++w) v += part[w * 512 + F.tid];
    __syncthreads();
    return v;
}
__device__ __forceinline__ void meta_store_bf16(Frame& F, const bf16* A16, const bf16* Bt, bf16* O, int ldo, int ncols, int per, const float* rs) {
    const int c0 = per * (int)blockIdx.x, fr = F.lane & 15;
    if (c0 >= ncols) return;
    const int n0 = c0 + fr; const float v = meta_gemm(F, A16, DM, Bt, DM, (fr < per && n0 < ncols) ? n0 : 0, 0);
    const int row = F.tid >> 5, col = F.tid & 31, n = c0 + col;
    const float sc = rs ? meta_rstd(F, rs) : 1.f;
    if (col < per && n < ncols) O[(size_t)(NREAL + row) * ldo + n] = (bf16)f2bf(v * sc);
}
__device__ __forceinline__ void meta_kvq(Frame& F, const bf16* A16, const bf16* Bt, bf16* KVQ, const float* rs, const float* gq, const float* gk, float qscale) {
    const int w = (int)blockIdx.x, fr = F.lane & 15;
    if (w >= 64) return;
    const float r = meta_rstd(F, rs);
    const int row = F.tid >> 5, j = F.tid & 31;
    if (w < 32) {
        const int vh = w & 15, base = (w >> 4) * 1024 + 256 * (vh >> 2) + 32 * (vh & 3);
        const float v0 = meta_gemm(F, A16, DM, Bt, DM, base + fr, base + 16 + fr) * r;
        const float v1 = meta_gemm(F, A16, DM, Bt, DM, base + 128 + fr, base + 128 + 16 + fr) * r;
        float ss = v0 * v0 + v1 * v1;
#pragma unroll
        for (int o = 1; o < 32; o <<= 1) ss += __shfl_xor(ss, o);
        const float rh = __builtin_amdgcn_rsqf(ss * (1.f / 64.f) + 1e-6f) * (w < 16 ? qscale : 1.f);
        const float* g = w < 16 ? gq : gk;
        bf16* o = KVQ + (size_t)(NREAL + row) * KVQ_LD + (w >> 4) * 1024 + vh * 64;
        o[j] = (bf16)f2bf(v0 * rh * g[j]); o[32 + j] = (bf16)f2bf(v1 * rh * g[32 + j]);
    } else {
        const int n0 = 2048 + 32 * (w - 32);
        const float v = meta_gemm(F, A16, DM, Bt, DM, n0 + fr, n0 + 16 + fr) * r;
        KVQ[(size_t)(NREAL + row) * KVQ_LD + n0 + j] = (bf16)f2bf(v);
    }
}
__device__ __forceinline__ void knorm0_phase(Frame& F, bf16* PROJ, const float* gk) {
    const int gw = blockIdx.x * NWAVES + F.wave, NGW = F.G * NWAVES, half = F.lane >> 5, c = F.lane & 31;
    const f32x4 g0 = *(const f32x4*)(gk + (c & 15) * 8), g1 = *(const f32x4*)(gk + (c & 15) * 8 + 4);
    for (int r2 = gw; r2 < NVALID / 2; r2 += NGW) {
        bf16* p = PROJ + (size_t)(2 * r2 + half) * PROJ_LD + 1024 + c * 8;
        const v4u w = *(const GAS v4u*)p;
        float v[8]; v[0] = bf2f(w.x & 0xffff); v[1] = bf2f(w.x >> 16); v[2] = bf2f(w.y & 0xffff); v[3] = bf2f(w.y >> 16); v[4] = bf2f(w.z & 0xffff); v[5] = bf2f(w.z >> 16); v[6] = bf2f(w.w & 0xffff); v[7] = bf2f(w.w >> 16);
        float ss = 0.f;
#pragma unroll
        for (int e = 0; e < 8; ++e) ss += v[e] * v[e];
#pragma unroll
        for (int o = 1; o < 16; o <<= 1) ss += __shfl_xor(ss, o);
        const float rstd = __builtin_amdgcn_rsqf(ss * (1.f / 128.f) + 1e-6f);
        v4u o; o.x = pk2(v[0] * rstd * g0[0], v[1] * rstd * g0[1]); o.y = pk2(v[2] * rstd * g0[2], v[3] * rstd * g0[3]); o.z = pk2(v[4] * rstd * g1[0], v[5] * rstd * g1[1]); o.w = pk2(v[6] * rstd * g1[2], v[7] * rstd * g1[3]);
        *(GAS v4u*)p = o;
    }
}
__device__ __forceinline__ void meta_resid(Frame& F, const bf16* A16, int K, const bf16* Bt, const float* base_f32, const bf16* base_bf, bf16* xb, float* rowss) {
    const int c0 = 4 * (int)blockIdx.x, fr = F.lane & 15;
    const float v = meta_gemm(F, A16, K, Bt, K, fr < 4 ? c0 + fr : 0, 0);
    const int row = F.tid >> 5, col = F.tid & 31;
    float o = 0.f;
    if (col < 4) { o = (base_f32 ? base_f32[row * DM + c0 + col] : bf2f(base_bf[(size_t)(NREAL + row) * DM + c0 + col])) + v; xb[(size_t)(NREAL + row) * DM + c0 + col] = (bf16)f2bf(o); }
    if (rowss) { float ss = o * o; ss += __shfl_xor(ss, 1); ss += __shfl_xor(ss, 2); if (col == 0) rowss[row * 256 + (int)blockIdx.x] = ss; }
}
__device__ __forceinline__ void meta_upconv(Frame& F, const bf16* A16, const bf16* Bt, bf16* G, float* UH, const float* cw, const float* cb, const float* rs, int f0) {
    const int fr = F.lane & 15, ff = f0 + (fr < 11 ? fr : 0), gr = 256 * (ff >> 7) + (ff & 127);
    const float v = meta_gemm(F, A16, DM, Bt, DM, gr, gr + 128);
    LAS float* U = (LAS float*)F.lds;
    U[F.tid] = v * meta_rstd(F, rs);
    __syncthreads();
    const int row = F.tid >> 5, j = F.tid & 31;
    if (j < 11) { const int f = f0 + j;
        float x[2];
#pragma unroll
        for (int gv = 0; gv < 2; ++gv) { const int c = gv * DFF + f, jj = j + 16 * gv;
            const float u0 = U[row * 32 + jj], u1 = row >= 1 ? U[(row - 1) * 32 + jj] : 0.f, u2 = row >= 2 ? U[(row - 2) * 32 + jj] : 0.f;
            x[gv] = cb[c] + cw[c] * u2 + cw[5632 + c] * u1 + cw[11264 + c] * u0;
            if (row >= 14) UH[(size_t)(256 * 4 + 2 + (row - 14)) * 5632 + c] = u0; }
        const float s = 1.f / (1.f + exp2f(-x[0] * L2E));
        G[(size_t)(NREAL + row) * DFF + f] = (bf16)f2bf(x[0] * s * x[1]); }
    __syncthreads();
}
__device__ __forceinline__ void idxcols_gemm(Frame& F, const bf16* X, const bf16* Wt, bf16* PROJ) {
    constexpr int BROW = 2048 + 16;
    LAS unsigned char* bl = F.lds;
    { const GAS v4u* src = (const GAS v4u*)(Wt + (size_t)2048 * DM);
      for (int i = F.tid; i < 72 * 128; i += NWAVES * 64) *(LAS v4u*)(bl + (i >> 7) * BROW + (i & 127) * 16) = src[i]; }
    __syncthreads();
    const int fr = F.lane & 15, fq = F.lane >> 4, rt = F.wave & 3, cg = F.wave >> 2;
    const int row = 64 * (int)blockIdx.x + 16 * rt + fr;
    const bf16* ap = X + (size_t)row * DM + 8 * fq;
    const int nct = cg == 0 ? 3 : 2;
    const LAS unsigned char* bp[3];
#pragma unroll
    for (int c = 0; c < 3; ++c) { int n = 16 * (3 * cg + c) + fr; if (n > 71) n = 71; bp[c] = bl + n * BROW + 16 * fq; }
    f32x4 acc[3] = {{0.f, 0.f, 0.f, 0.f}, {0.f, 0.f, 0.f, 0.f}, {0.f, 0.f, 0.f, 0.f}};
#pragma unroll
    for (int h = 0; h < 2; ++h) {
        bf16x8 af[16];
#pragma unroll
        for (int i = 0; i < 16; ++i) af[i] = *(const bf16x8*)(ap + 512 * h + 32 * i);
#pragma unroll
        for (int i = 0; i < 16; ++i) {
#pragma unroll
            for (int c = 0; c < 3; ++c) if (c < nct) { const bf16x8 b = *(const LAS bf16x8*)(bp[c] + 2 * (512 * h + 32 * i)); acc[c] = __builtin_amdgcn_mfma_f32_16x16x32_bf16(b, af[i], acc[c], 0, 0, 0); } }
    }
#pragma unroll
    for (int c = 0; c < 3; ++c) if (c < nct) { const int col = 2048 + 16 * (3 * cg + c) + 4 * fq;
        if (col < PROJ_LD) { v2u w; w.x = cvtpk(acc[c][0], acc[c][1]); w.y = cvtpk(acc[c][2], acc[c][3]); *(GAS v2u*)(PROJ + (size_t)row * PROJ_LD + col) = w; } }
    __syncthreads();
}
__device__ __forceinline__ void fixup_panel(Frame& F, const float* UH, bf16* G, const float* cw, const float* cb, int pm) {
    LAS float* wl = (LAS float*)F.lds;
    for (int i = F.tid; i < 4 * 5632 / 4; i += NWAVES * 64) { const f32x4 v = i < 3 * 5632 / 4 ? *(const f32x4*)(cw + 4 * i) : *(const f32x4*)(cb + 4 * i - 3 * 5632); *(LAS f32x4*)(wl + 4 * i) = v; }
    __syncthreads();
    for (int i = F.tid; i < 4 * (DFF / 4); i += NWAVES * 64) {
        const int f = (i % (DFF / 4)) * 4, blk = 4 * pm + i / (DFF / 4);
        const int pblk = (blk & 31) == 0 ? 256 : blk - 1;
        const float* hb = UH + (size_t)blk * 4 * 5632; const float* pb = UH + (size_t)pblk * 4 * 5632;
        f32x4 x0[2], x1[2];
#pragma unroll
        for (int gv = 0; gv < 2; ++gv) {
            const int c = gv * DFF + f;
            const f32x4 t2 = *(const f32x4*)(pb + 2 * 5632 + c), t3 = *(const f32x4*)(pb + 3 * 5632 + c);
            const f32x4 h0 = *(const f32x4*)(hb + c), h1 = *(const f32x4*)(hb + 5632 + c);
            const f32x4 w0 = *(const LAS f32x4*)(wl + c), w1 = *(const LAS f32x4*)(wl + 5632 + c), w2 = *(const LAS f32x4*)(wl + 11264 + c), bb = *(const LAS f32x4*)(wl + 16896 + c);
            x0[gv] = bb + w0 * t2 + w1 * t3 + w2 * h0; x1[gv] = bb + w0 * t3 + w1 * h0 + w2 * h1;
        }
        f32x4 o0, o1;
#pragma unroll
        for (int e = 0; e < 4; ++e) { const float s0 = __builtin_amdgcn_rcpf(1.f + __builtin_amdgcn_exp2f(-x0[0][e] * L2E)), s1 = __builtin_amdgcn_rcpf(1.f + __builtin_amdgcn_exp2f(-x1[0][e] * L2E));
            o0[e] = x0[0][e] * s0 * x0[1][e]; o1[e] = x1[0][e] * s1 * x1[1][e]; }
        v2u w; w.x = pk2(o0[0], o0[1]); w.y = pk2(o0[2], o0[3]); *(GAS v2u*)(G + (size_t)(blk * 64) * DFF + f) = w;
        w.x = pk2(o1[0], o1[1]); w.y = pk2(o1[2], o1[3]); *(GAS v2u*)(G + (size_t)(blk * 64 + 1) * DFF + f) = w;
    }
    asm volatile("s_waitcnt vmcnt(0)" ::: "memory");
    __syncthreads();
}

#define KSWZ(row, colB) ((row) * 256 + ((colB) ^ (((row) & 7) << 4)))
#define SBAR() __builtin_amdgcn_sched_barrier(0)
__device__ __forceinline__ int v_st(int k, int c) { const int kk = (k & ~0xC) | ((k & 4) << 1) | ((k & 8) >> 1); return ((kk >> 3) * 4 + (c >> 5)) * 512 + ((kk & 7) * 32 + (c & 31)) * 2; }
__device__ __forceinline__ int v_rd_base(int lane) { return ((lane & 3) << 3) | (((lane >> 2) & 3) << 6) | (((lane >> 4) & 1) << 5) | (((lane >> 5) & 1) << 8); }
constexpr int v_rd_off(int d0, int ks, int half) { return d0 * 512 + ks * 4096 + half * 2048; }
__device__ __forceinline__ int crow(int r, int hi) { return (r & 3) + 8 * (r >> 2) + 4 * hi; }
template <int KB, int ND0>
__device__ __forceinline__ void qkt(f32x16& p0, f32x16& p1, const LAS char* K_lds, int r32, int hi, const bf16x8* qr, int kmapoff, float cinit) {
#pragma unroll
    for (int r = 0; r < 16; ++r) { p0[r] = cinit; p1[r] = cinit; }
    const LAS char* kb[4];
#pragma unroll
    for (int dd = 0; dd < 4; ++dd) kb[dd] = K_lds + KB * SHM_K + KSWZ(r32, (dd * 16 + hi * 8) * 2) + kmapoff;
    if constexpr (ND0 == 4) {
        bf16x8 kf[8];
#pragma unroll
        for (int d0 = 0; d0 < 4; ++d0) { kf[2 * d0] = *reinterpret_cast<const LAS bf16x8*>(kb[d0]); kf[2 * d0 + 1] = *reinterpret_cast<const LAS bf16x8*>(kb[d0] + 32 * 256); }
        SBAR();
#pragma unroll
        for (int d0 = 0; d0 < 4; ++d0) { p0 = __builtin_amdgcn_mfma_f32_32x32x16_bf16(kf[2 * d0], qr[d0], p0, 0, 0, 0); p1 = __builtin_amdgcn_mfma_f32_32x32x16_bf16(kf[2 * d0 + 1], qr[d0], p1, 0, 0, 0); }
    } else {
#pragma unroll
    for (int d0 = 0; d0 < ND0; ++d0) { const LAS char* a = kb[d0 & 3] + (d0 >> 2) * 128;
        const bf16x8 b0 = *reinterpret_cast<const LAS bf16x8*>(a);
        const bf16x8 b1 = *reinterpret_cast<const LAS bf16x8*>(a + 32 * 256);
        p0 = __builtin_amdgcn_mfma_f32_32x32x16_bf16(b0, qr[d0], p0, 0, 0, 0);
        p1 = __builtin_amdgcn_mfma_f32_32x32x16_bf16(b1, qr[d0], p1, 0, 0, 0); }
    }
}
template <int VB>
__device__ __forceinline__ void pv_tile(f32x16* o, int vb0, bf16x8 pa0, bf16x8 pa1, bf16x8 pa2, bf16x8 pa3) {
#define TRRD(dst, off) asm volatile("ds_read_b64_tr_b16 %0, %1 offset:%2" : "=&v"(dst) : "v"(vb0), "i"(off) : "memory")
#define PV_D0(d0) do { s16x4 l0, l1, l2, l3, h0, h1, h2, h3; constexpr int b_ = VB * SHM_V + v_rd_off(d0, 0, 0);   \
        TRRD(l0, b_); TRRD(h0, b_ + 2048); TRRD(l1, b_ + 4096); TRRD(h1, b_ + 6144); TRRD(l2, b_ + 8192); TRRD(h2, b_ + 10240); TRRD(l3, b_ + 12288); TRRD(h3, b_ + 14336); \
        asm volatile("s_waitcnt lgkmcnt(0)" ::: "memory"); SBAR();   \
        o[d0] = __builtin_amdgcn_mfma_f32_32x32x16_bf16(pa0, (bf16x8){l0[0], l0[1], l0[2], l0[3], h0[0], h0[1], h0[2], h0[3]}, o[d0], 0, 0, 0);   \
        o[d0] = __builtin_amdgcn_mfma_f32_32x32x16_bf16(pa1, (bf16x8){l1[0], l1[1], l1[2], l1[3], h1[0], h1[1], h1[2], h1[3]}, o[d0], 0, 0, 0);   \
        o[d0] = __builtin_amdgcn_mfma_f32_32x32x16_bf16(pa2, (bf16x8){l2[0], l2[1], l2[2], l2[3], h2[0], h2[1], h2[2], h2[3]}, o[d0], 0, 0, 0);   \
        o[d0] = __builtin_amdgcn_mfma_f32_32x32x16_bf16(pa3, (bf16x8){l3[0], l3[1], l3[2], l3[3], h3[0], h3[1], h3[2], h3[3]}, o[d0], 0, 0, 0); } while (0)
    PV_D0(0); PV_D0(1); PV_D0(2); PV_D0(3);
#undef PV_D0
#undef TRRD
}
__device__ __forceinline__ float swap32f(float v) { auto rr = __builtin_amdgcn_permlane32_swap(__float_as_uint(v), __float_as_uint(v), false, false); return __uint_as_float(rr[1]); }
__device__ __forceinline__ float partialSM(f32x16& p0, f32x16& p1, float& m_reg) {
    float pmax = p0[0];
#pragma unroll
    for (int r = 1; r < 16; ++r) pmax = fmaxf(pmax, p0[r]);
#pragma unroll
    for (int r = 0; r < 16; ++r) pmax = fmaxf(pmax, p1[r]);
    { auto rr = __builtin_amdgcn_permlane32_swap(__float_as_uint(pmax), __float_as_uint(pmax), false, false);
      pmax = fmaxf(__uint_as_float(rr[0]), __uint_as_float(rr[1])); }
    const bool need = !__all(pmax - m_reg <= 8.f);
    const float mn = need ? fmaxf(m_reg, pmax) : m_reg; const float alpha = __builtin_amdgcn_exp2f(m_reg - mn); m_reg = mn;
    const float mneg = -m_reg;
#pragma unroll
    for (int r = 0; r < 16; ++r) { p0[r] = __builtin_amdgcn_exp2f(p0[r] + mneg); p1[r] = p1[r] + mneg; }
    return alpha;
}
__device__ __forceinline__ void finishSM(f32x16& p0, f32x16& p1, float alpha, float& l_reg, bf16x8& pa0, bf16x8& pa1, bf16x8& pa2, bf16x8& pa3) {
#pragma unroll
    for (int r = 0; r < 16; ++r) p1[r] = __builtin_amdgcn_exp2f(p1[r]);
    float ps = 0.f;
#pragma unroll
    for (int r = 0; r < 16; ++r) ps += p0[r];
#pragma unroll
    for (int r = 0; r < 16; ++r) ps += p1[r];
    { auto rr = __builtin_amdgcn_permlane32_swap(__float_as_uint(ps), __float_as_uint(ps), false, false);
      ps = __uint_as_float(rr[0]) + __uint_as_float(rr[1]); }
    l_reg = l_reg * alpha + ps;
#define PK4(P, B_, OUT) do { unsigned a0 = cvtpk(P[B_+0], P[B_+1]), a1 = cvtpk(P[B_+2], P[B_+3]);                          \
        unsigned b0 = cvtpk(P[B_+4], P[B_+5]), b1 = cvtpk(P[B_+6], P[B_+7]);                                             \
        auto r0 = __builtin_amdgcn_permlane32_swap(a0, b0, false, false); auto r1 = __builtin_amdgcn_permlane32_swap(a1, b1, false, false); \
        v4u w = {r0[0], r1[0], r0[1], r1[1]}; OUT = *reinterpret_cast<bf16x8*>(&w); } while (0)
    PK4(p0, 0, pa0); PK4(p0, 8, pa1); PK4(p1, 0, pa2); PK4(p1, 8, pa3);
#undef PK4
}
__device__ __forceinline__ float softmax_tile(f32x16& p0, f32x16& p1, float& m_reg, float& l_reg, bf16x8& pa0, bf16x8& pa1, bf16x8& pa2, bf16x8& pa3) {
    float pmax = p0[0];
#pragma unroll
    for (int r = 1; r < 16; ++r) pmax = fmaxf(pmax, p0[r]);
#pragma unroll
    for (int r = 0; r < 16; ++r) pmax = fmaxf(pmax, p1[r]);
    { auto rr = __builtin_amdgcn_permlane32_swap(__float_as_uint(pmax), __float_as_uint(pmax), false, false);
      pmax = fmaxf(__uint_as_float(rr[0]), __uint_as_float(rr[1])); }
    const bool need = !__all(pmax - m_reg <= 8.f);
    const float mn = need ? fmaxf(m_reg, pmax) : m_reg; const float alpha = __builtin_amdgcn_exp2f(m_reg - mn); m_reg = mn;
    const float mneg = -m_reg;
#pragma unroll
    for (int r = 0; r < 16; ++r) { p0[r] = __builtin_amdgcn_exp2f(p0[r] + mneg); p1[r] = __builtin_amdgcn_exp2f(p1[r] + mneg); }
    float ps = 0.f;
#pragma unroll
    for (int r = 0; r < 16; ++r) ps += p0[r];
#pragma unroll
    for (int r = 0; r < 16; ++r) ps += p1[r];
    { auto rr = __builtin_amdgcn_permlane32_swap(__float_as_uint(ps), __float_as_uint(ps), false, false);
      ps = __uint_as_float(rr[0]) + __uint_as_float(rr[1]); }
    l_reg = l_reg * alpha + ps;
#define PK4(P, B_, OUT) do { unsigned a0 = cvtpk(P[B_+0], P[B_+1]), a1 = cvtpk(P[B_+2], P[B_+3]);                          \
        unsigned b0 = cvtpk(P[B_+4], P[B_+5]), b1 = cvtpk(P[B_+6], P[B_+7]);                                             \
        auto r0 = __builtin_amdgcn_permlane32_swap(a0, b0, false, false); auto r1 = __builtin_amdgcn_permlane32_swap(a1, b1, false, false); \
        v4u w = {r0[0], r1[0], r0[1], r1[1]}; OUT = *reinterpret_cast<bf16x8*>(&w); } while (0)
    PK4(p0, 0, pa0); PK4(p0, 8, pa1); PK4(p1, 0, pa2); PK4(p1, 8, pa3);
#undef PK4
    return alpha;
}
template <int CTRL> __device__ __forceinline__ float dppx(float v) { return __builtin_bit_cast(float, __builtin_amdgcn_update_dpp(0, __builtin_bit_cast(int, v), CTRL, 0xF, 0xF, false)); }
__device__ __forceinline__ float lane_xor1(float v) { return dppx<0xB1>(v); }
__device__ __forceinline__ float half_sum32(float v) {
    v += dppx<0xB1>(v); v += dppx<0x4E>(v); v += dppx<0x141>(v); v += dppx<0x128>(v);
    auto s = __builtin_amdgcn_permlane16_swap(__float_as_uint(v), __float_as_uint(v), false, false);
    return __uint_as_float(s[0]) + __uint_as_float(s[1]);
}
struct AttnArgs {
    const bf16* buf; int ld;
    const unsigned long long* mask;
    bf16* O;
    const float* subg; float lam; float oscale;
    const float* gq;
    int var;
};
template <bool DIFF>
__device__ __forceinline__ void attn_unit(const AttnArgs& A, LAS unsigned char* lds, int u_b, int u_h, int u_q, gu32* qctr, volatile LAS unsigned* qslot) {
    const int VAR = PROBE_VAR ? A.var : 0;
    int tid_l = threadIdx.x; asm volatile("" : "+v"(tid_l));
    const int tid = tid_l, wid = __builtin_amdgcn_readfirstlane(tid >> 6), lane = tid & 63, r32 = lane & 31, hi = lane >> 5;
    const bool meta = u_b < 0;
    constexpr int ND0 = DIFF ? 4 : 8;
    const int qsub = DIFF ? (wid >> 1) : (wid & 1);
    const int qrow0 = meta ? NREAL + 32 * qsub : u_b * SEQ + (DIFF ? 128 : 64) * u_q + 32 * qsub;
    const int qpos0 = meta ? 32 * qsub : 16 + (DIFF ? 128 : 64) * u_q + 32 * qsub;
    const int nvalid = meta ? (qsub == 0 ? 16 : 0) : 32;
    const int qhead = DIFF ? (2 * u_h + (wid & 1)) : (4 * u_h + (wid >> 1));
    const int bhead = DIFF ? u_h : qhead;
    const int qcol = DIFF ? qhead * 64 : qhead * 128;
    const int kcol = 1024 + u_h * 128, vcol = (DIFF ? 2048 : 1280) + u_h * 128;
    const int kmapoff = DIFF ? (wid & 1) * 128 : 0;
    const int NT = meta ? 1 : (DIFF ? 2 * u_q + 3 : u_q + 2);
    const int my_nt = meta ? 1 : (DIFF ? 2 * u_q + 2 + (qsub >> 1) : NT);
    const int kbrow = meta ? 0 : u_b * SEQ;
    const LAS char* V_lds = (const LAS char*)lds + ALDS_V; const LAS char* K_lds = (const LAS char*)lds + ALDS_K;
    LAS float* wsf = (LAS float*)(lds + ALDS_WS) + wid * 64; LAS float* li_l = wsf; LAS float* al_l = wsf + 32;
    const LAS float* BT = (const LAS float*)(lds + ALDS_BT) + bhead * BT_N;
    const int sr = tid >> 4, sc = (tid & 15) * 8, vst0 = v_st(sr, sc), vst1 = v_st(32 + sr, sc), kws = KSWZ(sr, sc * 2);
    const int vb0 = (int)(unsigned)(size_t)V_lds + v_rd_base(lane);
    const int qrl = qrow0 + r32 < NVALID ? qrow0 + r32 : NVALID - 1;
    const int qpos = meta ? (qrl - NREAL) : qpos0 + r32;
    bf16x8 qr[ND0];
#pragma unroll
    for (int d0 = 0; d0 < ND0; ++d0) qr[d0] = *(const bf16x8*)(A.buf + (size_t)qrl * A.ld + qcol + d0 * 16 + hi * 8);
    if (!DIFF) {
        float ss = 0.f;
#pragma unroll
        for (int d0 = 0; d0 < ND0; ++d0)
#pragma unroll
            for (int e = 0; e < 8; ++e) { const float v = bf2f((unsigned short)qr[d0][e]); ss += v * v; }
        { auto rr = __builtin_amdgcn_permlane32_swap(__float_as_uint(ss), __float_as_uint(ss), false, false); ss = __uint_as_float(rr[0]) + __uint_as_float(rr[1]); }
        const float rq = __builtin_amdgcn_rsqf(ss * (1.f / 128.f) + EPS) * (0.08838834764831845f * L2E);
#pragma unroll
        for (int d0 = 0; d0 < ND0; ++d0) { const f32x4 ga = *(const f32x4*)(A.gq + d0 * 16 + hi * 8), gb = *(const f32x4*)(A.gq + d0 * 16 + hi * 8 + 4);
            v4u w; w.x = cvtpk(bf2f((unsigned short)qr[d0][0]) * rq * ga[0], bf2f((unsigned short)qr[d0][1]) * rq * ga[1]); w.y = cvtpk(bf2f((unsigned short)qr[d0][2]) * rq * ga[2], bf2f((unsigned short)qr[d0][3]) * rq * ga[3]);
            w.z = cvtpk(bf2f((unsigned short)qr[d0][4]) * rq * gb[0], bf2f((unsigned short)qr[d0][5]) * rq * gb[1]); w.w = cvtpk(bf2f((unsigned short)qr[d0][6]) * rq * gb[2], bf2f((unsigned short)qr[d0][7]) * rq * gb[3]);
            qr[d0] = *reinterpret_cast<bf16x8*>(&w); }
    }
    const unsigned long long* mrow = DIFF ? nullptr : A.mask + (size_t)qrl * MASKW;
    const float biasFar = __builtin_bit_cast(float, __builtin_amdgcn_readfirstlane(__builtin_bit_cast(int, BT[0])));
    float m_reg = -1e30f, l_reg = 0.f; f32x16 o[4] = {};
    bf16x8 st_k0, st_k1, st_v0, st_v1;
    const int half = wid >> 2;
#define KROW(t_, slot) ((VAR == 1 || (t_) == 0) ? NREAL + ((slot) < 16 ? (slot) : 15) : kbrow + 64 * ((t_) - 1) + (slot))
#define KLOAD(t_) do { st_k0 = *(const bf16x8*)(A.buf + (size_t)KROW(t_, sr) * A.ld + sc + kcol); st_k1 = *(const bf16x8*)(A.buf + (size_t)KROW(t_, 32 + sr) * A.ld + sc + kcol); } while (0)
#define VLOAD(t_) do { st_v0 = *(const bf16x8*)(A.buf + (size_t)KROW(t_, sr) * A.ld + sc + vcol); st_v1 = *(const bf16x8*)(A.buf + (size_t)KROW(t_, 32 + sr) * A.ld + sc + vcol); } while (0)
#define KWRITE(t_) do { const int kb_ = ((t_) & 1) * SHM_K; *(LAS bf16x8*)((LAS char*)K_lds + kb_ + kws) = st_k0; *(LAS bf16x8*)((LAS char*)K_lds + kb_ + kws + 32 * 256) = st_k1; } while (0)
#define VWRITE(t_) do { const int vb_ = ((t_) & 1) * SHM_V; *(LAS bf16x8*)((LAS char*)V_lds + vb_ + vst0) = st_v0; *(LAS bf16x8*)((LAS char*)V_lds + vb_ + vst1) = st_v1; } while (0)
#define TRRD(dst, off) asm volatile("ds_read_b64_tr_b16 %0, %1 offset:%2" : "=&v"(dst) : "v"(vbx_), "i"(off) : "memory")
#define PVR_I(d0, L0, L1, L2, L3, H0, H1, H2, H3) do { constexpr int b_ = v_rd_off(d0, 0, 0); \
        TRRD(L0, b_); TRRD(H0, b_ + 2048); TRRD(L1, b_ + 4096); TRRD(H1, b_ + 6144); TRRD(L2, b_ + 8192); TRRD(H2, b_ + 10240); TRRD(L3, b_ + 12288); TRRD(H3, b_ + 14336); } while (0)
#define PVM_I(d0, NW, L0, L1, L2, L3, H0, H1, H2, H3) do { asm volatile("s_waitcnt lgkmcnt(" #NW ")" : "+v"(L0), "+v"(L1), "+v"(L2), "+v"(L3), "+v"(H0), "+v"(H1), "+v"(H2), "+v"(H3) :: "memory"); SBAR();     \
        o[d0] = __builtin_amdgcn_mfma_f32_32x32x16_bf16(pa0, (bf16x8){L0[0], L0[1], L0[2], L0[3], H0[0], H0[1], H0[2], H0[3]}, o[d0], 0, 0, 0); \
        o[d0] = __builtin_amdgcn_mfma_f32_32x32x16_bf16(pa1, (bf16x8){L1[0], L1[1], L1[2], L1[3], H1[0], H1[1], H1[2], H1[3]}, o[d0], 0, 0, 0); \
        o[d0] = __builtin_amdgcn_mfma_f32_32x32x16_bf16(pa2, (bf16x8){L2[0], L2[1], L2[2], L2[3], H2[0], H2[1], H2[2], H2[3]}, o[d0], 0, 0, 0); \
        o[d0] = __builtin_amdgcn_mfma_f32_32x32x16_bf16(pa3, (bf16x8){L3[0], L3[1], L3[2], L3[3], H3[0], H3[1], H3[2], H3[3]}, o[d0], 0, 0, 0); } while (0)
#define PVR(d0, S) PVR_I(d0, S)
#define PVM(d0, NW, S) PVM_I(d0, NW, S)
#define VSA va0, va1, va2, va3, va4, va5, va6, va7
#define VSB vb_0, vb_1, vb_2, vb_3, vb_4, vb_5, vb_6, vb_7
#define PV_TILE(vt_) do { const int vbx_ = vb0 + ((vt_) & 1) * SHM_V; s16x4 VSA, VSB; \
        PVR(0, VSA); PVR(1, VSB); PVM(0, 8, VSA); PVR(2, VSA); PVM(1, 8, VSB); PVR(3, VSB); PVM(2, 8, VSA); PVM(3, 0, VSB); } while (0)
    { bf16x8 h_k0 = {}, h_k1 = {}; KLOAD(0); VLOAD(0);
      if (NT > 1) { h_k0 = *(const bf16x8*)(A.buf + (size_t)KROW(1, sr) * A.ld + sc + kcol); h_k1 = *(const bf16x8*)(A.buf + (size_t)KROW(1, 32 + sr) * A.ld + sc + kcol); }
      KWRITE(0); VWRITE(0);
      if (NT > 1) { *(LAS bf16x8*)((LAS char*)K_lds + SHM_K + kws) = h_k0; *(LAS bf16x8*)((LAS char*)K_lds + SHM_K + kws + 32 * 256) = h_k1; } }
    __syncthreads();
    if (half) __syncthreads();
    f32x16 p0, p1; bf16x8 pa0, pa1, pa2, pa3;
    unsigned nxt_ = 0u;
    for (int t = 0; t < NT; ++t) {
        if (t == NT - 1 && tid == 0) nxt_ = __hip_atomic_fetch_add(qctr, 1u, RLX_AGENT);
        const int kt = t + 1 + half, vt = t + half;
        const bool doK = kt < NT && kt >= 2, doV = vt < NT && vt >= 1;
        unsigned long long mw_ = 0ull; if (!DIFF) mw_ = mrow[t];
        if (doK) KLOAD(kt);
        if (doV) VLOAD(vt);
        const int kpos0 = t == 0 ? 0 : 16 + 64 * (t - 1);
        const bool nearT = kpos0 + 63 - qpos0 > -91;
        const float ci_ = (DIFF && t >= my_nt) ? -__builtin_inff() : (nearT ? 0.f : biasFar);
        SBAR(); if (VAR == 6) { _Pragma("unroll") for (int r = 0; r < 16; ++r) { p0[r] = ci_; p1[r] = ci_; } } else qkt<0, ND0>(p0, p1, K_lds + (t & 1) * SHM_K, r32, hi, qr, kmapoff, ci_);
        if (t > 0 && VAR != 4) { PV_TILE(t - 1); }
        __syncthreads();
        if (nearT) { const LAS float* bp = BT + (kpos0 - qpos + BT_OFF + 4 * hi);
#pragma unroll
            for (int r = 0; r < 16; ++r) { const int cr = (r & 3) + 8 * (r >> 2); p0[r] += bp[cr]; p1[r] += bp[cr + 32]; } }
        if (!DIFF) { const unsigned lo = (unsigned)mw_ >> (4 * hi), hw = (unsigned)(mw_ >> 32) >> (4 * hi);
#pragma unroll
            for (int r = 0; r < 16; ++r) { const int cr = (r & 3) + 8 * (r >> 2);
                const int m0 = ((int)(lo << (31 - cr))) >> 31, m1 = ((int)(hw << (31 - cr))) >> 31;
                p0[r] = __uint_as_float((__float_as_uint(p0[r]) & (unsigned)m0) | (0xff800000u & ~(unsigned)m0));
                p1[r] = __uint_as_float((__float_as_uint(p1[r]) & (unsigned)m1) | (0xff800000u & ~(unsigned)m1)); } }
        else if (t == 0) { const float NEG = -__builtin_inff();
#pragma unroll
            for (int r = 8; r < 16; ++r) p0[r] = NEG;
#pragma unroll
            for (int r = 0; r < 16; ++r) p1[r] = NEG; }
        float alpha = 1.f;
        if (VAR == 7) { v4u w_ = {__float_as_uint(p0[0]), __float_as_uint(p0[5]), __float_as_uint(p1[3]), __float_as_uint(p1[9])}; pa0 = *reinterpret_cast<bf16x8*>(&w_); pa1 = pa0; pa2 = pa0; pa3 = pa0; }
        else alpha = softmax_tile(p0, p1, m_reg, l_reg, pa0, pa1, pa2, pa3);
        if (__any(alpha < 1.f)) { if (hi == 0) al_l[r32] = alpha; asm volatile("s_waitcnt lgkmcnt(0)" ::: "memory");
#pragma unroll
            for (int d_ = 0; d_ < 4; ++d_)
#pragma unroll
                for (int r = 0; r < 16; ++r) o[d_][r] *= al_l[crow(r, hi)]; }
        if (doK) KWRITE(kt);
        if (doV) VWRITE(vt);
        __syncthreads();
    }
    PV_TILE(NT - 1);
    if (tid == 0) *qslot = nxt_;
    if (!half) __syncthreads();
    __syncthreads();
#undef KROW
#undef KLOAD
#undef VLOAD
#undef KWRITE
#undef VWRITE
#undef TRRD
#undef PVR_I
#undef PVM_I
#undef PVR
#undef PVM
#undef VSA
#undef VSB
#undef PV_TILE
    if (hi == 0) li_l[r32] = l_reg; asm volatile("s_waitcnt lgkmcnt(0)" ::: "memory");
    float rli[16];
#pragma unroll
    for (int r = 0; r < 16; ++r) rli[r] = __builtin_amdgcn_rcpf(li_l[crow(r, hi)]);
    if (!DIFF) {
        bf16* Ow = A.O + (size_t)(VAR ? (qrow0 & 4095) : qrow0) * DM + qhead * 128;
#pragma unroll
        for (int r = 0; r < 16; ++r) { const int orow = crow(r, hi);
#pragma unroll
            for (int d0 = 0; d0 < 4; ++d0) { const float v = o[d0][r] * rli[r]; const float vn = lane_xor1(v);
                if ((r32 & 1) == 0 && orow < nvalid) *(unsigned*)(Ow + (size_t)orow * DM + d0 * 32 + r32) = cvtpk(v, vn); } }
        __syncthreads();
    } else {
        LAS float* X = (LAS float*)lds + (wid >> 1) * 4096;
        const int map = wid & 1;
        if (map == 1) {
#pragma unroll
            for (int d0 = 0; d0 < 4; ++d0)
#pragma unroll
                for (int r = 0; r < 16; ++r) X[(d0 * 16 + r) * 64 + lane] = o[d0][r] * rli[r] * A.lam;
        }
        __syncthreads();
        if (map == 0) {
            float g4[4];
#pragma unroll
            for (int d0 = 0; d0 < 4; ++d0) g4[d0] = A.subg[d0 * 32 + r32] * A.oscale;
            bf16* Ow = A.O + (size_t)(VAR ? (qrow0 & 4095) : qrow0) * DM + u_h * 128;
#pragma unroll
            for (int r = 0; r < 16; ++r) { const int orow = crow(r, hi);
                float dv[4]; float ss = 0.f;
#pragma unroll
                for (int d0 = 0; d0 < 4; ++d0) { dv[d0] = o[d0][r] * rli[r] - X[(d0 * 16 + r) * 64 + lane]; ss += dv[d0] * dv[d0]; }
                ss = half_sum32(ss);
                const float rs = __builtin_amdgcn_rsqf(ss * (1.f / 128.f) + EPS);
#pragma unroll
                for (int d0 = 0; d0 < 4; ++d0) { const float v = dv[d0] * rs * g4[d0]; const float vn = lane_xor1(v);
                    if ((r32 & 1) == 0 && orow < nvalid) *(unsigned*)(Ow + (size_t)orow * DM + d0 * 32 + r32) = cvtpk(v, vn); } }
        }
        __syncthreads();
    }
}
template <bool DIFF>
__device__ __forceinline__ void attn_phase(Frame& F, const AttnArgs& A, const float* bt_global, gu32* qhead) {
    for (int i = F.tid; i < 8 * BT_N; i += NWAVES * 64) ((LAS float*)(F.lds + ALDS_BT))[i] = bt_global[i];
    __syncthreads();
    constexpr int NQT = DIFF ? 16 : 32, NH = DIFF ? 8 : 2, NREALU = NB * NH * NQT, NU = NREALU + NH;
    if (F.tid == 0) F.MISC[4] = __hip_atomic_fetch_add(qhead, 1u, RLX_AGENT);
    for (;;) {
        __syncthreads();
        const int u = __builtin_amdgcn_readfirstlane((int)F.MISC[4]);
        __syncthreads();
        if (u >= NU) break;
        const bool real = u >= NH; const int ur = u - NH, bh = ur % (NB * NH);
        attn_unit<DIFF>(A, F.lds, real ? bh / NH : -1, real ? bh % NH : u, real ? NQT - 1 - ur / (NB * NH) : 0, qhead, F.MISC + 4);
    }
}

constexpr int N_PHASES = 19;
__global__ void __launch_bounds__(NWAVES * 64, 2) yoco_fwd(Params P) {
    extern __shared__ __attribute__((aligned(16))) unsigned char lds[];
    Frame F;
    F.lds = (LAS unsigned char*)lds;
    F.MISC = (volatile LAS unsigned*)(F.lds + MISC_OFF);
    F.tid = threadIdx.x; F.lane = F.tid & 63; F.wave = __builtin_amdgcn_readfirstlane(F.tid >> 6);
    F.G = gridDim.x;
    unsigned char* ws = P.ws;
    F.ctl = (gu32*)(ws + WS_CTL);
    for (int u = F.tid; u < (LDS_BYTES - LDSCTL_OFF) / 4; u += NWAVES * 64) ((LAS unsigned*)(F.lds + LDSCTL_OFF))[u] = 0u;
    __syncthreads();
    const int lo = P.ph_lo, hi = P.ph_hi;
    const bool use_bar = (hi - lo) > 1;
    XcdBarrier bar; bar.bar = (unsigned*)(F.ctl + CW_BAR); bar.x = 0; bar.st = nullptr;
    if (use_bar) bar = xcd_barrier_post((unsigned*)(F.ctl + CW_BAR), F.MISC + 8);
#define IN(k) (lo <= (k) && (k) < hi)
#define RELAUNDER() asm volatile("" : "+v"(F.tid), "+v"(F.lane))
#define SEAM(k) do { if (IN(k) && IN((k) + 1)) xcd_barrier(bar); } while (0)
    bf16* const X0 = (bf16*)(ws + WS_X0); bf16* const X1 = (bf16*)(ws + WS_X1);
    bf16* const PROJ = (bf16*)(ws + WS_PROJ); bf16* const KVQ = (bf16*)(ws + WS_KVQ); bf16* const G = (bf16*)(ws + WS_G);
    float* const SC = (float*)(ws + WS_SC); unsigned long long* const MASK = (unsigned long long*)(ws + WS_MASK);
    float* const UH = (float*)(ws + WS_UH); float* const HMETA = (float*)(ws + WS_HMETA); const float* const BTG = (const float*)(ws + WS_BT);
    const int bid = (int)blockIdx.x;
    float* const RS0 = (float*)(ws + WS_PS); float* const RS1 = RS0 + 262144; float* const RS2 = RS1 + 262144;
    float* const RM0 = (float*)(ws + WS_PSM); float* const RM1 = RM0 + 4096; float* const RM2 = RM1 + 4096;

    if (IN(0)) { RELAUNDER(); p0_prologue(F, P); } SEAM(0);
    if (IN(1)) { RELAUNDER(); meta_store_bf16(F, X0 + (size_t)NREAL * DM, (const bf16*)(ws + WS_WIN), PROJ, PROJ_LD, PROJ_LD, 9, nullptr);
        idxcols_gemm(F, X0, (const bf16*)(ws + WS_WIN), PROJ);
        pg8::Gemm g{X0, (const bf16*)(ws + WS_WIN), NREAL, 2048, DM}; pg8::StaticOrder S; S.init(NREAL, 2048, F.G, bid);
        pg8::EpiBf16G E{PROJ, PROJ_LD, 2048, nullptr};
        pg8::gemm_phase<pg8::EpiBf16G, pg8::StaticOrder, PG8_ALIGN, PG8_SP2>(F.lds, g, S, E); } SEAM(1);
    if (IN(2)) { RELAUNDER(); knorm0_phase(F, PROJ, P.kn_a); }
    if (IN(3)) { RELAUNDER(); idxsel_phase(F, PROJ, MASK); } SEAM(3);
    if (IN(4)) { RELAUNDER(); AttnArgs A{PROJ, PROJ_LD, MASK, X1, nullptr, 0.f, 0.f, P.qn_a, 0};
#if PROBE_VAR && PROBE_VAR_A
        _Pragma("nounroll") for (int rep = 0; rep < 2; ++rep) { A.var = rep ? 0 : PROBE_VAR; A.O = rep ? X1 : (bf16*)(ws + 190 * MiB); attn_phase<false>(F, A, BTG, F.ctl + CW_Q0 + 1024 * (1 - rep)); }
#else
        attn_phase<false>(F, A, BTG, F.ctl + CW_Q0);
#endif

#if DUP_ATTN
        attn_phase<false>(F, A, BTG, F.ctl + CW_Q0 + 256);
#endif
        } SEAM(4);
    if (IN(5)) { RELAUNDER(); meta_resid(F, X1 + (size_t)NREAL * DM, DM, (const bf16*)(ws + WS_WOA), P.meta, nullptr, X0, RM0);
        pg8::Gemm g{X1, (const bf16*)(ws + WS_WOA), NREAL, DM, DM}; pg8::StaticOrder S; S.init(NREAL, DM, F.G, bid);
        pg8::EpiResid<false> E{P.x, nullptr, X0, RS0};
        pg8::gemm_phase<pg8::EpiResid<false>, pg8::StaticOrder, PG8_ALIGN, PG8_SP2>(F.lds, g, S, E); } SEAM(5);
    if (IN(7)) { RELAUNDER();
        pg8::Gemm g{X0, (const bf16*)(ws + WS_WUP0), NREAL, 2 * DFF, DM}; pg8::StaticOrder S; S.init(NREAL, 2 * DFF, F.G, bid);
        pg8::EpiConv E{G, UH, P.conv_w, P.conv_b, RS0};
        pg8::gemm_phase<pg8::EpiConv, pg8::StaticOrder, PG8_ALIGN, PG8_SP2>(F.lds, g, S, E);
        if (bid >= 128) { __syncthreads();
            meta_upconv(F, X0 + (size_t)NREAL * DM, (const bf16*)(ws + WS_WUP0), G, UH, P.conv_w, P.conv_b, RM0, 22 * (bid - 128));
            meta_upconv(F, X0 + (size_t)NREAL * DM, (const bf16*)(ws + WS_WUP0), G, UH, P.conv_w, P.conv_b, RM0, 22 * (bid - 128) + 11);
            convert_l1_weights(F, P, (bid - 128) * NWAVES + F.wave, 128 * NWAVES); }
        } SEAM(7);
    if (IN(9)) { RELAUNDER(); meta_resid(F, G + (size_t)NREAL * DFF, DFF, (const bf16*)(ws + WS_WDN0), nullptr, X0, X1, RM1);
        pg8::Gemm g{G, (const bf16*)(ws + WS_WDN0), NREAL, DM, DFF}; pg8::StaticOrder S; S.init(NREAL, DM, F.G, bid);
        { pg8::Unit u0; if (S.next(0, u0)) fixup_panel(F, UH, G, P.conv_w, P.conv_b, u0.pm); }
        pg8::EpiResid<true> E{X0, nullptr, X1, RS1};
        pg8::gemm_phase<pg8::EpiResid<true>, pg8::StaticOrder, PG8_ALIGN, PG8_SP2>(F.lds, g, S, E); } SEAM(9);
#if PROBE_DRY
    if (IN(10)) { RELAUNDER(); pg8::Gemm g{G, (const bf16*)(ws + WS_WDN0), NREAL, DM, DFF}; pg8::StaticOrder S; S.init(NREAL, DM, F.G, bid);
        pg8::EpiResid<true> E{X0, (float*)(ws + 236 * MiB), nullptr, nullptr};
        pg8::gemm_phase<pg8::EpiResid<true>, pg8::StaticOrder, PG8_ALIGN, PG8_SP2>(F.lds, g, S, E); }
#endif
    if (IN(11)) { RELAUNDER(); meta_kvq(F, X1 + (size_t)NREAL * DM, (const bf16*)(ws + WS_WKVQ), KVQ, RM1, P.qn_b, P.kn_b, 0.125f * L2E);
        pg8::Gemm g{X1, (const bf16*)(ws + WS_WKVQ), NREAL, KVQ_LD, DM}; pg8::StaticOrder S; S.init(NREAL, KVQ_LD, F.G, bid);
        pg8::EpiKVQ E{KVQ, RS1, P.qn_b, P.kn_b, 0.125f * L2E};
        pg8::gemm_phase<pg8::EpiKVQ, pg8::StaticOrder, PG8_ALIGN, PG8_SP2>(F.lds, g, S, E); } SEAM(11);
    if (IN(13)) { RELAUNDER(); const float lam = *(const float*)(ws + WS_LAM); const float lam_init = 0.8f - 0.6f * 0.7408182206817179f;
        AttnArgs A{KVQ, KVQ_LD, nullptr, X0, P.subln_b, lam, 1.f - lam_init, nullptr, 0};
#if PROBE_VAR && !PROBE_VAR_A
        _Pragma("nounroll") for (int rep = 0; rep < 2; ++rep) { A.var = rep ? 0 : PROBE_VAR; A.O = rep ? X0 : (bf16*)(ws + 214 * MiB); attn_phase<true>(F, A, BTG, F.ctl + CW_Q1 + 1024 * (1 - rep)); }
#else
        attn_phase<true>(F, A, BTG, F.ctl + CW_Q1);
#endif

#if DUP_ATTN
        attn_phase<true>(F, A, BTG, F.ctl + CW_Q1 + 256);
#endif
        } SEAM(13);
    if (IN(14)) { RELAUNDER(); meta_resid(F, X0 + (size_t)NREAL * DM, DM, (const bf16*)(ws + WS_WOB), nullptr, X1, X1, RM2);
        pg8::Gemm g{X0, (const bf16*)(ws + WS_WOB), NREAL, DM, DM}; pg8::StaticOrder S; S.init(NREAL, DM, F.G, bid);
        pg8::EpiResid<true> E{X1, nullptr, X1, RS2};
        pg8::gemm_phase<pg8::EpiResid<true>, pg8::StaticOrder, PG8_ALIGN, PG8_SP2>(F.lds, g, S, E); } SEAM(14);
    if (IN(16)) { RELAUNDER();
        pg8::Gemm g{X1, (const bf16*)(ws + WS_WUP1), NREAL, 2 * DFF, DM}; pg8::StaticOrder S; S.init(NREAL, 2 * DFF, F.G, bid);
        pg8::EpiConv E{G, UH, P.conv_w + 3 * 2 * DFF, P.conv_b + 2 * DFF, RS2};
        pg8::gemm_phase<pg8::EpiConv, pg8::StaticOrder, PG8_ALIGN, PG8_SP2>(F.lds, g, S, E);
        if (bid >= 128) { __syncthreads();
            meta_upconv(F, X1 + (size_t)NREAL * DM, (const bf16*)(ws + WS_WUP1), G, UH, P.conv_w + 3 * 2 * DFF, P.conv_b + 2 * DFF, RM2, 22 * (bid - 128));
            meta_upconv(F, X1 + (size_t)NREAL * DM, (const bf16*)(ws + WS_WUP1), G, UH, P.conv_w + 3 * 2 * DFF, P.conv_b + 2 * DFF, RM2, 22 * (bid - 128) + 11); }
        } SEAM(16);
    if (IN(18)) { RELAUNDER(); pg8::Gemm g{G, (const bf16*)(ws + WS_WDN1), NREAL, DM, DFF}; pg8::StaticOrder S; S.init(NREAL, DM, F.G, bid);
        { pg8::Unit u0; if (S.next(0, u0)) fixup_panel(F, UH, G, P.conv_w + 3 * 2 * DFF, P.conv_b + 2 * DFF, u0.pm); }
        pg8::EpiResid<true> E{X1, P.out, nullptr, nullptr};
        pg8::gemm_phase<pg8::EpiResid<true>, pg8::StaticOrder, PG8_ALIGN, PG8_SP2>(F.lds, g, S, E); }
#undef IN
#undef RELAUNDER
#undef SEAM
}

extern "C" void kernel_launch(void* const* d_in, const int* in_sizes, int n_in, void* d_out, int out_size, void* d_ws, size_t ws_size, hipStream_t stream) {
    static int grid = 0;
    if (grid == 0) {
        if (n_in != 24 || false || in_sizes[0] != NREAL * DM || out_size != NREAL * DM || ws_size < WS_END) { fprintf(stderr, "kernel_launch: unexpected shapes (n_in %d, in0 %d, out %d, ws %zu)\n", n_in, n_in > 0 ? in_sizes[0] : -1, out_size, ws_size); grid = -1; return; }
        int dev = 0, cus = 0, per_cu = 0;
        if (hipGetDevice(&dev) != hipSuccess || hipDeviceGetAttribute(&cus, hipDeviceAttributeMultiprocessorCount, dev) != hipSuccess) { grid = -1; return; }
        if (hipFuncSetAttribute((const void*)yoco_fwd, hipFuncAttributeMaxDynamicSharedMemorySize, LDS_BYTES) != hipSuccess) { fprintf(stderr, "kernel_launch: hipFuncSetAttribute failed\n"); grid = -1; return; }
        if (hipOccupancyMaxActiveBlocksPerMultiprocessor(&per_cu, (const void*)yoco_fwd, NWAVES * 64, LDS_BYTES) != hipSuccess || per_cu < 1)
            fprintf(stderr, "kernel_launch: note: occupancy query reports %d workgroups per CU\n", per_cu);
        (void)hipGetLastError();
        grid = cus;
        if (grid != 256) { fprintf(stderr, "kernel_launch: this kernel is laid out for 256 CUs (got %d)\n", grid); grid = -1; return; }
    }
    if (grid < 0) return;
    if (hipMemsetAsync((char*)d_ws + WS_CTL, 0, CTL_ZERO_BYTES, stream) != hipSuccess) return;
    Params p{};
    const float** pf = (const float**)&p;
    for (int i = 0; i < 24; ++i) pf[i] = (const float*)d_in[i];
    p.out = (float*)d_out; p.ws = (unsigned char*)d_ws;
#if MK_N_LAUNCHES == 1
    p.ph_lo = 0; p.ph_hi = N_PHASES;
    hipLaunchKernelGGL(yoco_fwd, dim3(grid), dim3(NWAVES * 64), LDS_BYTES, stream, p);
#else
    static const int seq[] = { PROBE_SEQ };
    for (unsigned i = 0; i < sizeof(seq) / sizeof(seq[0]); ++i) { const int k = seq[i];
        if (k == 4) (void)hipMemsetAsync((char*)d_ws + WS_CTL + CW_Q0 * 4, 0, 2048, stream);
        if (k == 13) (void)hipMemsetAsync((char*)d_ws + WS_CTL + CW_Q1 * 4, 0, 2048, stream);
        p.ph_lo = k; p.ph_hi = k + 1; hipLaunchKernelGGL(yoco_fwd, dim3(grid), dim3(NWAVES * 64), LDS_BYTES, stream, p); }
#endif
}
```

```cpp
#define MK_N_LAUNCHES 1
#ifndef PROBE_SEQ
#define PROBE_SEQ 0,1,2,3,4,5,6,7,8,9,10,11,12,13,14,15,16,17,18
#endif
#ifndef PROBE_VAR
#define PROBE_VAR 0
#endif
#ifndef PROBE_VAR_A
#define PROBE_VAR_A 0
#endif
#ifndef PROBE_DRY
#define PROBE_DRY 0
#endif
#ifndef DUP_ATTN
#define DUP_ATTN 0
#endif
#ifndef DUP_SEL
#define DUP_SEL 0
#endif
#include <hip/hip_runtime.h>
#include <cstdio>
#include <cstdint>
namespace pg8 {
#define PG8_LAS __attribute__((address_space(3)))
typedef unsigned short bf16_t;
typedef short bf16x8 __attribute__((ext_vector_type(8)));
typedef float f32x4 __attribute__((ext_vector_type(4)));
typedef unsigned u32x4 __attribute__((ext_vector_type(4)));
constexpr int BM = 256, BK = 64, HALF = 128, HTB = HALF * BK * 2  , STAGE_BYTES = 8 * HTB, NXCD = 8, WGM = 8;

__host__ __device__ __forceinline__ int lds_byte(int r, int c) { const int st = (r >> 4) * 2 + (c >> 5), rr = r & 15, cc = c & 31, ob = rr * 64 + cc * 2; return st * 1024 + (ob ^ (((ob >> 9) & 1) << 5)); }
__host__ __device__ __forceinline__ void stage_rc(int b, int& R, int& C) { const int st = b / 1024, sb = b % 1024, swz = sb ^ (((sb >> 9) & 1) << 5); R = (st >> 1) * 16 + swz / 64; C = (st & 1) * 32 + (swz % 64) / 2; }
__host__ __device__ __forceinline__ int perm32(int rho) { const int n = rho >> 4, i = rho & 15; return 8 * (i >> 2) + 4 * n + (i & 3); }

struct Unit { int pm, pn; };
struct Gemm { const bf16_t* A; const bf16_t* Bt; int M, N, K; };

struct StaticOrder {
    int nM, nN, nwg, G, c;
    __host__ __device__ void init(int M, int N, int G_, int c_) { nM = M / BM; nN = N / BM; nwg = nM * nN; G = G_; c = c_; }
    __host__ __device__ __forceinline__ bool next(int i, Unit& u) const {
        const long L = (long)i * G + c; if (L >= nwg) return false;
        int wgid = (int)L; { const int q = nwg / NXCD, r = nwg % NXCD, xcd = wgid % NXCD, off = wgid / NXCD; wgid = (xcd < r ? xcd * (q + 1) : r * (q + 1) + (xcd - r) * q) + off; }
        const int nig = WGM * nN, gid = wgid / nig, fm = gid * WGM, gsz = (nM - fm) < WGM ? (nM - fm) : WGM;
        u.pm = fm + ((wgid % nig) % gsz); u.pn = (wgid % nig) / gsz; return true;
    }
    __device__ __forceinline__ void a_ready(const Unit&) const {}
    __device__ __forceinline__ void done(const Unit&) const {}
};


constexpr int NREAL = 16384, NVALID = 16400;
__device__ __forceinline__ unsigned cvt_pk_bf16(float lo, float hi) { unsigned r; asm volatile("s_nop 0\n\tv_cvt_pk_bf16_f32 %0, %1, %2" : "=v"(r) : "v"(lo), "v"(hi)); return r; }
typedef unsigned u32x2 __attribute__((ext_vector_type(2)));

__device__ __forceinline__ float row_rstd(const float* ps, int row, int fq) {
    const f32x4 v = *(const f32x4*)(ps + (size_t)row * 16 + 4 * fq); float t = (v[0] + v[1]) + (v[2] + v[3]);
    t += __shfl_xor(t, 16); t += __shfl_xor(t, 32); return __builtin_amdgcn_rsqf(t * (1.f / 1024.f) + 1e-6f);
}
struct EpiBf16G {
    static constexpr bool PERM = true, AFTER_DRAIN = false;
    bf16_t* O; int ldc; int ncols; const float* rs;
    __device__ __forceinline__ void operator()(const f32x4 (&acc)[2][2][4][2], const Unit& u, int wr, int wc, int fr, int fq) const {
        const int row0 = u.pm * BM + wr * 64 + fr, col0 = u.pn * BM + wc * 32 + 8 * fq;
#pragma unroll
        for (int ai = 0; ai < 2; ++ai)
#pragma unroll
            for (int m = 0; m < 4; ++m) { const int row = row0 + ai * HALF + m * 16;
                if (row < NVALID) { bf16_t* rowp = O + (size_t)row * ldc;
                    const float sc = rs ? row_rstd(rs, row, fq) : 1.f;
#pragma unroll
                    for (int bj = 0; bj < 2; ++bj) { const int col = col0 + bj * HALF;
                        if (col < ncols) { const f32x4 v0 = acc[ai][bj][m][0] * sc, v1 = acc[ai][bj][m][1] * sc;
                            u32x4 w; w.x = cvt_pk_bf16(v0[0], v0[1]); w.y = cvt_pk_bf16(v0[2], v0[3]); w.z = cvt_pk_bf16(v1[0], v1[1]); w.w = cvt_pk_bf16(v1[2], v1[3]);
                            *(u32x4*)(rowp + col) = w; } } } }
    }
};
struct EpiKVQ {
    static constexpr bool PERM = true, AFTER_DRAIN = false;
    bf16_t* O; const float* rs; const float* gq; const float* gk; float qscale;
    __device__ __forceinline__ void operator()(const f32x4 (&acc)[2][2][4][2], const Unit& u, int wr, int wc, int fr, int fq) const {
        const int row0 = u.pm * BM + wr * 64 + fr;
        if (u.pn < 8) {
            const float* g = (u.pn < 4 ? gq : gk) + 8 * fq; const float hs = u.pn < 4 ? qscale : 1.f;
            f32x4 gv[2][2];
#pragma unroll
            for (int bj = 0; bj < 2; ++bj)
#pragma unroll
                for (int n = 0; n < 2; ++n) gv[bj][n] = *(const f32x4*)(g + 32 * bj + 4 * n);
            const int colb = (u.pn >> 2) * 1024 + (4 * (u.pn & 3) + wc) * 64 + 8 * fq;
#pragma unroll
            for (int ai = 0; ai < 2; ++ai)
#pragma unroll
                for (int m = 0; m < 4; ++m) { const int row = row0 + ai * HALF + m * 16; const float r = row_rstd(rs, row, fq);
                    float ss = 0.f;
#pragma unroll
                    for (int bj = 0; bj < 2; ++bj)
#pragma unroll
                        for (int n = 0; n < 2; ++n) { const f32x4 x = acc[ai][bj][m][n]; ss += (x[0] * x[0] + x[1] * x[1]) + (x[2] * x[2] + x[3] * x[3]); }
                    ss += __shfl_xor(ss, 16); ss += __shfl_xor(ss, 32);
                    const float sc = r * __builtin_amdgcn_rsqf(ss * r * r * (1.f / 64.f) + 1e-6f) * hs;
                    bf16_t* rowp = O + (size_t)row * 3072 + colb;
#pragma unroll
                    for (int bj = 0; bj < 2; ++bj) { const f32x4 v0 = acc[ai][bj][m][0] * sc * gv[bj][0], v1 = acc[ai][bj][m][1] * sc * gv[bj][1];
                        u32x4 w; w.x = cvt_pk_bf16(v0[0], v0[1]); w.y = cvt_pk_bf16(v0[2], v0[3]); w.z = cvt_pk_bf16(v1[0], v1[1]); w.w = cvt_pk_bf16(v1[2], v1[3]);
                        *(u32x4*)(rowp + 32 * bj) = w; } }
        } else {
            const int col0 = u.pn * BM + wc * 32 + 8 * fq;
#pragma unroll
            for (int ai = 0; ai < 2; ++ai)
#pragma unroll
                for (int m = 0; m < 4; ++m) { const int row = row0 + ai * HALF + m * 16; const float sc = row_rstd(rs, row, fq);
                    bf16_t* rowp = O + (size_t)row * 3072 + col0;
#pragma unroll
                    for (int bj = 0; bj < 2; ++bj) { const f32x4 v0 = acc[ai][bj][m][0] * sc, v1 = acc[ai][bj][m][1] * sc;
                        u32x4 w; w.x = cvt_pk_bf16(v0[0], v0[1]); w.y = cvt_pk_bf16(v0[2], v0[3]); w.z = cvt_pk_bf16(v1[0], v1[1]); w.w = cvt_pk_bf16(v1[2], v1[3]);
                        *(u32x4*)(rowp + bj * HALF) = w; } }
        }
    }
};
template <bool BASE_BF16>
struct EpiResid {
    static constexpr bool PERM = false, AFTER_DRAIN = false;
    const void* base; float* out; bf16_t* xb; float* rowss;
    __device__ __forceinline__ void operator()(const f32x4 (&acc)[2][2][4][2], const Unit& u, int wr, int wc, int fr, int fq) const {
        const int row0 = u.pm * BM + wr * 64 + fr, col0 = u.pn * BM + wc * 32 + 4 * fq;
#pragma unroll
        for (int ai = 0; ai < 2; ++ai)
#pragma unroll
            for (int m = 0; m < 4; ++m) { const int row = row0 + ai * HALF + m * 16;
                float* op = out ? out + (size_t)((!PROBE_DRY || xb || out == base) ? row : (row & 4095)) * 1024 : nullptr; bf16_t* xp = xb ? xb + (size_t)row * 1024 : nullptr;
                float ss = 0.f;
#pragma unroll
                for (int bj = 0; bj < 2; ++bj)
#pragma unroll
                    for (int n = 0; n < 2; ++n) { const int col = col0 + bj * HALF + n * 16;
                        f32x4 b;
                        if (BASE_BF16) { const u32x2 w = *(const u32x2*)((const bf16_t*)base + (size_t)row * 1024 + col);
                            b[0] = __builtin_bit_cast(float, w.x << 16); b[1] = __builtin_bit_cast(float, w.x & 0xffff0000u); b[2] = __builtin_bit_cast(float, w.y << 16); b[3] = __builtin_bit_cast(float, w.y & 0xffff0000u); }
                        else b = *(const f32x4*)((const float*)base + (size_t)row * 1024 + col);
                        const f32x4 o = b + acc[ai][bj][m][n];
                        if (out) *(f32x4*)(op + col) = o;
                        if (xb) { u32x2 w; w.x = cvt_pk_bf16(o[0], o[1]); w.y = cvt_pk_bf16(o[2], o[3]); *(u32x2*)(xp + col) = w;
                            ss += (o[0] * o[0] + o[1] * o[1]) + (o[2] * o[2] + o[3] * o[3]); } }
                if (xb) { ss += __shfl_xor(ss, 16); ss += __shfl_xor(ss, 32); if (fq == 0) rowss[(size_t)row * 16 + u.pn * 4 + wc] = ss; } }
    }
};
template <int CTRL> __device__ __forceinline__ float dppf(float old, float src) {
    return __builtin_bit_cast(float, __builtin_amdgcn_update_dpp(__builtin_bit_cast(int, old), __builtin_bit_cast(int, src), CTRL, 0xF, 0xF, false));
}
#define CT_(x, s, w, ctl) "v_fmac_f32_dpp " x ", " s ", " w " " ctl " row_mask:0xf bank_mask:0xf\n\t"
__device__ __forceinline__ void conv_taps_cur(f32x4& x, const f32x4 c, const f32x4 w1, const f32x4 w0) {
    float x0 = x[0], x1 = x[1], x2 = x[2], x3 = x[3];
    asm("s_nop 1\n\t"
        CT_("%0", "%4", "%8", "row_shr:1") CT_("%1", "%5", "%9", "row_shr:1") CT_("%2", "%6", "%10", "row_shr:1") CT_("%3", "%7", "%11", "row_shr:1")
        CT_("%0", "%4", "%12", "row_shr:2") CT_("%1", "%5", "%13", "row_shr:2") CT_("%2", "%6", "%14", "row_shr:2") CT_("%3", "%7", "%15", "row_shr:2")
        : "+v"(x0), "+v"(x1), "+v"(x2), "+v"(x3)
        : "v"(c[0]), "v"(c[1]), "v"(c[2]), "v"(c[3]), "v"(w1[0]), "v"(w1[1]), "v"(w1[2]), "v"(w1[3]), "v"(w0[0]), "v"(w0[1]), "v"(w0[2]), "v"(w0[3]));
    x = (f32x4){x0, x1, x2, x3};
}
__device__ __forceinline__ void conv_taps_prev(f32x4& x, const f32x4 p, const f32x4 w1, const f32x4 w0) {
    float x0 = x[0], x1 = x[1], x2 = x[2], x3 = x[3];
    asm("s_nop 1\n\t"
        CT_("%0", "%4", "%8", "row_shl:15") CT_("%1", "%5", "%9", "row_shl:15") CT_("%2", "%6", "%10", "row_shl:15") CT_("%3", "%7", "%11", "row_shl:15")
        CT_("%0", "%4", "%12", "row_shl:14") CT_("%1", "%5", "%13", "row_shl:14") CT_("%2", "%6", "%14", "row_shl:14") CT_("%3", "%7", "%15", "row_shl:14")
        : "+v"(x0), "+v"(x1), "+v"(x2), "+v"(x3)
        : "v"(p[0]), "v"(p[1]), "v"(p[2]), "v"(p[3]), "v"(w1[0]), "v"(w1[1]), "v"(w1[2]), "v"(w1[3]), "v"(w0[0]), "v"(w0[1]), "v"(w0[2]), "v"(w0[3]));
    x = (f32x4){x0, x1, x2, x3};
}
#undef CT_
struct EpiConv {
    static constexpr bool PERM = false, AFTER_DRAIN = false;
    bf16_t* G;
    float* UH;
    const float* cw;
    const float* cb;
    const float* rs;
    __device__ __forceinline__ void operator()(const f32x4 (&acc)[2][2][4][2], const Unit& u, int wr, int wc, int fr, int fq) const {
        const float NL2E = -1.4426950408889634f, RNL2E = -0.6931471805599453f;
        float rsc[2][4];
#pragma unroll
        for (int ai = 0; ai < 2; ++ai)
#pragma unroll
            for (int m = 0; m < 4; ++m) rsc[ai][m] = row_rstd(rs, u.pm * BM + ai * HALF + wr * 64 + m * 16 + fr, fq);
#pragma unroll
        for (int n = 0; n < 2; ++n) {
            const int f = u.pn * 128 + wc * 32 + n * 16 + 4 * fq;
            const f32x4 wg0 = *(const f32x4*)(cw + f) * NL2E, wg1 = *(const f32x4*)(cw + 5632 + f) * NL2E, wg2 = *(const f32x4*)(cw + 11264 + f) * NL2E, bg = *(const f32x4*)(cb + f) * NL2E;
            const f32x4 wv0 = *(const f32x4*)(cw + 2816 + f) * RNL2E, wv1 = *(const f32x4*)(cw + 5632 + 2816 + f) * RNL2E, wv2 = *(const f32x4*)(cw + 11264 + 2816 + f) * RNL2E, bv = *(const f32x4*)(cb + 2816 + f) * RNL2E;
#pragma unroll
            for (int ai = 0; ai < 2; ++ai) {
                const int blk = u.pm * 4 + ai * 2 + wr, rowb = blk * 64;
                if (rowb < NVALID) {
                    f32x4 pg = {0.f, 0.f, 0.f, 0.f}, pv = {0.f, 0.f, 0.f, 0.f};
#pragma unroll
                    for (int m = 0; m < 4; ++m) {
                        const int row = rowb + m * 16 + fr;
                        const f32x4 cg = acc[ai][0][m][n] * rsc[ai][m], cv = acc[ai][1][m][n] * rsc[ai][m];
                        f32x4 xg = bg + wg2 * cg, xv = bv + wv2 * cv;
                        conv_taps_cur(xg, cg, wg1, wg0); conv_taps_cur(xv, cv, wv1, wv0);
                        if (m > 0) { conv_taps_prev(xg, pg, wg1, wg0); conv_taps_prev(xv, pv, wv1, wv0); }
                        f32x4 d, s;
#pragma unroll
                        for (int e = 0; e < 4; ++e) d[e] = __builtin_amdgcn_exp2f(xg[e]);
                        d = d + 1.f;
#pragma unroll
                        for (int e = 0; e < 4; ++e) s[e] = __builtin_amdgcn_rcpf(d[e]);
                        const f32x4 o = (xg * xv) * s;
                        if (row < NVALID && (m > 0 || fr >= 2)) { u32x2 w; w.x = cvt_pk_bf16(o[0], o[1]); w.y = cvt_pk_bf16(o[2], o[3]); *(u32x2*)(G + (size_t)row * 2816 + f) = w; }
                        if (m == 0 && fr < 2) { float* p = UH + (size_t)(blk * 4 + fr) * 5632 + f; *(f32x4*)p = cg; *(f32x4*)(p + 2816) = cv; }
                        if (m == 3 && fr >= 14) { float* p = UH + (size_t)(blk * 4 + 2 + (fr - 14)) * 5632 + f; *(f32x4*)p = cg; *(f32x4*)(p + 2816) = cv; }
                        pg = cg; pv = cv;
                    }
                }
            }
        }
    }
};
template <class Epi, class Sched, bool ALIGN_EPI = false, bool SP2 = false>
__device__ __forceinline__ void gemm_phase(PG8_LAS unsigned char* lds, const Gemm g, const Sched& S, const Epi& E) {
    int tid_l = threadIdx.x; asm volatile("" : "+v"(tid_l));
    const int tid = tid_l, wid = __builtin_amdgcn_readfirstlane(tid >> 6), lane = tid & 63, wr = wid >> 2, wc = wid & 3, fr = lane & 15, fq = lane >> 4;
    const int K = g.K, nt = K / BK;
    unsigned voffA[2], voffB[2];
#pragma unroll
    for (int i = 0; i < 2; ++i) { int R, C; stage_rc(tid * 16 + i * 8192, R, C); const int Rb = Epi::PERM ? ((R & ~31) + perm32(R & 31)) : R;
        voffA[i] = (unsigned)(R * K + C) * 2u; voffB[i] = (unsigned)(Rb * K + C) * 2u; }
    const size_t kstep = (size_t)(BK * 2);
    const size_t hstep = (size_t)HALF * K * 2;
    const size_t tstep = 2 * hstep;
    const unsigned ldsw = (unsigned)wid * 1024u;
    const int aoff = lds_byte(wr * 64 + fr, fq * 8), boff = lds_byte(wc * 32 + fr, fq * 8);
#define PG8_SA(b, h) (((b) * 2 + (h)) * HTB)
#define PG8_SB(b, h) ((4 + (b) * 2 + (h)) * HTB)
#define PG8_STAGE(bufoff, gbase, voff) do { _Pragma("unroll") for (int _i = 0; _i < 2; ++_i) \
        __builtin_amdgcn_global_load_lds((const unsigned*)((const char*)(gbase) + (voff)[_i]), (PG8_LAS unsigned*)(lds + (bufoff) + ldsw + _i * 8192), 16, 0, 0); } while (0)
#define PG8_LDA(dst, b, h) do { _Pragma("unroll") for (int m = 0; m < 4; ++m) _Pragma("unroll") for (int k = 0; k < 2; ++k) dst[m][k] = *(const PG8_LAS bf16x8*)(lds + PG8_SA(b, h) + aoff + m * 2048 + k * 1024); } while (0)
#define PG8_LDB(dst, b, h) do { _Pragma("unroll") for (int n = 0; n < 2; ++n) _Pragma("unroll") for (int k = 0; k < 2; ++k) dst[n][k] = *(const PG8_LAS bf16x8*)(lds + PG8_SB(b, h) + boff + n * 2048 + k * 1024); } while (0)
#define PG8_MMA(ai, bj, At, Bt) do { __builtin_amdgcn_s_setprio(1); _Pragma("unroll") for (int m = 0; m < 4; ++m) _Pragma("unroll") for (int n = 0; n < 2; ++n) _Pragma("unroll") for (int k = 0; k < 2; ++k) \
        acc[ai][bj][m][n] = __builtin_amdgcn_mfma_f32_16x16x32_bf16(Bt[n][k], At[m][k], acc[ai][bj][m][n], 0, 0, 0); __builtin_amdgcn_s_setprio(0); } while (0)
#define PG8_WAIT_V(n) asm volatile("s_waitcnt vmcnt(" #n ")" ::: "memory")
#define PG8_WAIT_L(n) asm volatile("s_waitcnt lgkmcnt(" #n ")" ::: "memory")
#define PG8_BAR __builtin_amdgcn_s_barrier()
#define PG8_SCHED __builtin_amdgcn_sched_barrier(0)
    Unit cur, nxt; int ui = 0;
    if (!S.next(0, cur)) return;
    f32x4 acc[2][2][4][2];
#pragma unroll
    for (int a = 0; a < 2; ++a)
#pragma unroll
        for (int b = 0; b < 2; ++b)
#pragma unroll
            for (int m = 0; m < 4; ++m)
#pragma unroll
                for (int n = 0; n < 2; ++n) acc[a][b][m][n] = (f32x4){0.f, 0.f, 0.f, 0.f};
    bf16x8 At[4][2], B0[2][2], B1[2][2];
    const char* cA = (const char*)g.A + (size_t)cur.pm * tstep; const char* cB = (const char*)g.Bt + (size_t)cur.pn * tstep;
    S.a_ready(cur);
    if constexpr (SP2) {
        PG8_STAGE(PG8_SB(0, 0), cB, voffB); PG8_STAGE(PG8_SB(0, 1), cB + hstep, voffB); PG8_STAGE(PG8_SA(0, 0), cA, voffA); PG8_STAGE(PG8_SA(0, 1), cA + hstep, voffA);
        if (wr == 1) PG8_BAR;
        PG8_WAIT_V(2); PG8_BAR;
        PG8_STAGE(PG8_SB(1, 0), cB + kstep, voffB); PG8_STAGE(PG8_SA(1, 0), cA + kstep, voffA); PG8_STAGE(PG8_SB(1, 1), cB + hstep + kstep, voffB);
        PG8_WAIT_V(6); PG8_BAR;
    } else {
        PG8_STAGE(PG8_SB(0, 0), cB, voffB); PG8_STAGE(PG8_SA(0, 0), cA, voffA); PG8_STAGE(PG8_SB(0, 1), cB + hstep, voffB); PG8_STAGE(PG8_SA(0, 1), cA + hstep, voffA);
        if (wr == 1) PG8_BAR;
        PG8_WAIT_V(4); PG8_BAR;
        PG8_STAGE(PG8_SB(1, 0), cB + kstep, voffB); PG8_STAGE(PG8_SA(1, 0), cA + kstep, voffA); PG8_STAGE(PG8_SB(1, 1), cB + hstep + kstep, voffB);
        PG8_WAIT_V(6); PG8_BAR;
    }
    for (;;) {
        const bool has_next = S.next(ui + 1, nxt);
        const char* nA = has_next ? (const char*)g.A + (size_t)nxt.pm * tstep : cA; const char* nB = has_next ? (const char*)g.Bt + (size_t)nxt.pn * tstep : cB;
        for (int t = 0; t < nt; t += 2) {
            const bool last = (t == nt - 2);
            const char* a1 = cA + (size_t)(t + 1) * kstep;
            const char* a2 = last ? nA : cA + (size_t)(t + 2) * kstep; const char* b2 = last ? nB : cB + (size_t)(t + 2) * kstep;
            const char* a3 = a2 + kstep; const char* b3 = b2 + kstep;
            if (last && has_next) S.a_ready(nxt);
            if constexpr (SP2) {
            PG8_LDB(B0, 0, 0); PG8_LDB(B1, 0, 1); PG8_SCHED; PG8_LDA(At, 0, 0); PG8_STAGE(PG8_SA(1, 1), a1 + hstep, voffA);
            PG8_WAIT_V(8); PG8_WAIT_L(0); PG8_BAR; PG8_MMA(0, 0, At, B0); PG8_MMA(0, 1, At, B1); PG8_BAR; PG8_SCHED;
            PG8_LDA(At, 0, 1); PG8_STAGE(PG8_SB(0, 0), b2, voffB); PG8_STAGE(PG8_SB(0, 1), b2 + hstep, voffB); PG8_STAGE(PG8_SA(0, 0), a2, voffA);
            PG8_WAIT_V(8); PG8_WAIT_L(0); PG8_BAR; PG8_MMA(1, 0, At, B0); PG8_MMA(1, 1, At, B1); PG8_BAR; PG8_SCHED;
            PG8_LDB(B0, 1, 0); PG8_LDB(B1, 1, 1); PG8_SCHED; PG8_LDA(At, 1, 0); PG8_STAGE(PG8_SA(0, 1), a2 + hstep, voffA);
            PG8_WAIT_V(8); PG8_WAIT_L(0); PG8_BAR; PG8_MMA(0, 0, At, B0); PG8_MMA(0, 1, At, B1); PG8_BAR; PG8_SCHED;
            PG8_LDA(At, 1, 1); PG8_STAGE(PG8_SB(1, 0), b3, voffB); PG8_STAGE(PG8_SB(1, 1), b3 + hstep, voffB); PG8_STAGE(PG8_SA(1, 0), a3, voffA);
            PG8_WAIT_V(8); PG8_WAIT_L(0); PG8_BAR; PG8_MMA(1, 0, At, B0); PG8_MMA(1, 1, At, B1); PG8_BAR; PG8_SCHED;
            } else {
            PG8_LDB(B0, 0, 0); PG8_SCHED; PG8_LDA(At, 0, 0); PG8_STAGE(PG8_SA(1, 1), a1 + hstep, voffA);
            PG8_WAIT_L(8); PG8_BAR; PG8_WAIT_L(0); PG8_MMA(0, 0, At, B0); PG8_BAR; PG8_SCHED;
            PG8_LDB(B1, 0, 1); PG8_STAGE(PG8_SB(0, 0), b2, voffB);
            PG8_BAR; PG8_WAIT_L(0); PG8_MMA(0, 1, At, B1); PG8_BAR;
            PG8_LDA(At, 0, 1); PG8_STAGE(PG8_SA(0, 0), a2, voffA);
            PG8_BAR; PG8_WAIT_L(0); PG8_MMA(1, 0, At, B0); PG8_BAR; PG8_SCHED;
            PG8_STAGE(PG8_SB(0, 1), b2 + hstep, voffB);
            PG8_WAIT_V(6); PG8_BAR; PG8_MMA(1, 1, At, B1); PG8_BAR;
            PG8_LDB(B0, 1, 0); PG8_SCHED; PG8_LDA(At, 1, 0); PG8_STAGE(PG8_SA(0, 1), a2 + hstep, voffA);
            PG8_WAIT_L(8); PG8_BAR; PG8_WAIT_L(0); PG8_MMA(0, 0, At, B0); PG8_BAR; PG8_SCHED;
            PG8_LDB(B1, 1, 1); PG8_STAGE(PG8_SB(1, 0), b3, voffB);
            PG8_BAR; PG8_WAIT_L(0); PG8_MMA(0, 1, At, B1); PG8_BAR;
            PG8_LDA(At, 1, 1); PG8_STAGE(PG8_SA(1, 0), a3, voffA);
            PG8_BAR; PG8_WAIT_L(0); PG8_MMA(1, 0, At, B0); PG8_BAR; PG8_SCHED;
            PG8_STAGE(PG8_SB(1, 1), b3 + hstep, voffB);
            PG8_WAIT_V(6); PG8_BAR; PG8_MMA(1, 1, At, B1); PG8_BAR;
            }
        }
        if constexpr (ALIGN_EPI) { if (wr == 0) PG8_BAR; }
        if constexpr (!Epi::AFTER_DRAIN) { E(acc, cur, wr, wc, fr, fq); S.done(cur); }
        if (!has_next) break;
#pragma unroll
        for (int a = 0; a < 2; ++a)
#pragma unroll
            for (int b = 0; b < 2; ++b)
#pragma unroll
                for (int m = 0; m < 4; ++m)
#pragma unroll
                    for (int n = 0; n < 2; ++n) acc[a][b][m][n] = (f32x4){0.f, 0.f, 0.f, 0.f};
        cur = nxt; cA = nA; cB = nB; ++ui;
        if constexpr (ALIGN_EPI) { if (wr == 1) PG8_BAR; }
    }
    PG8_WAIT_V(0);
    if constexpr (!ALIGN_EPI) { if (wr == 0) PG8_BAR; }
    PG8_BAR;
    if constexpr (Epi::AFTER_DRAIN) { E.fused(acc, cur, wr, wc, fr, fq, lds, wid, lane); S.done(cur); }
#undef PG8_SA
#undef PG8_SB
#undef PG8_STAGE
#undef PG8_LDA
#undef PG8_LDB
#undef PG8_MMA
#undef PG8_WAIT_V
#undef PG8_WAIT_L
#undef PG8_BAR
#undef PG8_SCHED
}
}

#ifndef PG8_SP2
#define PG8_SP2 true
#endif
#ifndef PG8_ALIGN
#define PG8_ALIGN true
#endif
#ifndef MK_N_LAUNCHES
#define MK_N_LAUNCHES 1
#endif
constexpr int NWAVES = 8;
constexpr int NREAL = 16384, NVALID = 16400, MROWS = 16640;
constexpr int DM = 1024, DFF = 2816, SEQ = 2048, NB = 8;
constexpr int PROJ_LD = 2120;
constexpr int KVQ_LD = 3072;
constexpr int MASKW = 34;
constexpr float EPS = 1e-6f, L2E = 1.4426950408889634f;
constexpr int BT_N = 288, BT_OFF = 224;
constexpr long SC_BATCH = 2195456;

constexpr size_t MiB = 1u << 20;
constexpr size_t WS_CTL = 0, CTL_ZERO_BYTES = 1 * MiB;
constexpr size_t WS_BT = 1 * MiB, WS_LAM = 1 * MiB + 16384, WS_HMETA = 1 * MiB + 65536;
constexpr size_t WS_WIN = 2 * MiB, WS_WOA = WS_WIN + 9 * MiB / 2, WS_WUP0 = WS_WOA + 2 * MiB, WS_WDN0 = WS_WUP0 + 11 * MiB, WS_WKVQ = WS_WDN0 + 11 * MiB / 2,
                 WS_WOB = WS_WKVQ + 6 * MiB, WS_WUP1 = WS_WOB + 2 * MiB, WS_WDN1 = WS_WUP1 + 11 * MiB, WS_WEND = WS_WDN1 + 11 * MiB / 2;
constexpr size_t WS_X0 = 50 * MiB, WS_X1 = WS_X0 + 65 * MiB / 2, WS_R = 115 * MiB;
constexpr size_t WS_PROJ = WS_R, WS_SC = WS_R + 135 * MiB / 2, WS_MASK = WS_R + 269 * MiB / 2;
constexpr size_t WS_G = WS_R, WS_UH = WS_R + 90 * MiB, WS_KVQ = WS_R;
constexpr size_t WS_END = 256 * MiB;
static_assert(WS_WEND <= WS_X0 && WS_X1 + (size_t)MROWS * DM * 2 <= WS_R, "ws map 1");
static_assert(WS_PROJ + (size_t)MROWS * PROJ_LD * 2 <= WS_SC && WS_SC + (size_t)NB * SC_BATCH * 4 <= WS_MASK && WS_MASK + (size_t)NVALID * MASKW * 8 <= WS_END, "ws map 2");
static_assert(WS_G + (size_t)MROWS * DFF * 2 <= WS_UH && WS_UH + (size_t)260 * 4 * 5632 * 4 <= WS_END && WS_KVQ + (size_t)MROWS * KVQ_LD * 2 <= WS_END, "ws map 3");
constexpr int CW_BAR = 4096;
constexpr int CW_Q0 = 64, CW_Q1 = 128;
constexpr size_t WS_PS = 230 * MiB, WS_PSM = 233 * MiB;

constexpr int RING_BYTES = 131072;
constexpr int LDS_BYTES = 163840;
constexpr int LDSCTL_OFF = LDS_BYTES - 1024, MISC_OFF = LDSCTL_OFF + 320;
constexpr int SHM_K = 16384, SHM_V = 16384;
constexpr int ALDS_V = 0, ALDS_K = 2 * SHM_V, ALDS_WS = 2 * SHM_V + 2 * SHM_K, ALDS_BT = ALDS_WS + NWAVES * 64 * 4;
static_assert(ALDS_BT + 8 * BT_N * 4 <= RING_BYTES, "attention LDS");

#define GAS __attribute__((address_space(1)))
#define LAS __attribute__((address_space(3)))
typedef unsigned short bf16;
typedef unsigned v4u __attribute__((ext_vector_type(4)));
typedef unsigned v2u __attribute__((ext_vector_type(2)));
typedef float f32x4 __attribute__((ext_vector_type(4)));
typedef float f32x16 __attribute__((ext_vector_type(16)));
typedef short bf16x8 __attribute__((ext_vector_type(8)));
typedef short s16x4 __attribute__((ext_vector_type(4)));
typedef GAS unsigned gu32;
#define RLX_AGENT __ATOMIC_RELAXED, __HIP_MEMORY_SCOPE_AGENT
#define LDS_WAIT() asm volatile("s_waitcnt lgkmcnt(0)" ::: "memory")
__device__ __forceinline__ unsigned f2bf(float f) { unsigned u = __builtin_bit_cast(unsigned, f); return (u + 0x7fffu + ((u >> 16) & 1u)) >> 16; }
__device__ __forceinline__ unsigned pk2(float lo, float hi) { return f2bf(lo) | (f2bf(hi) << 16); }
__device__ __forceinline__ float bf2f(unsigned short h) { return __builtin_bit_cast(float, (unsigned)h << 16); }
__device__ __forceinline__ unsigned cvtpk(float lo, float hi) { unsigned r; asm volatile("s_nop 0\n\tv_cvt_pk_bf16_f32 %0, %1, %2" : "=v"(r) : "v"(lo), "v"(hi)); return r; }
#define XB_TMO      128
#define XB_XCNT(j)  (256  + 64 * (j))
#define XB_XSUB(j)  (1280 + 64 * (j))
#define XB_XGEN(j)  (2304 + 64 * (j))
#define XB_TOP      3328
#define XB_TOPGEN   3392
#define XCD_BAR_WORDS 3456
#define XB_SPIN_CAP (1u << 18)

__device__ __forceinline__ unsigned xb_ld(unsigned* p)              { return __hip_atomic_load(p, __ATOMIC_RELAXED, __HIP_MEMORY_SCOPE_AGENT); }
__device__ __forceinline__ unsigned xb_add(unsigned* p, unsigned v) { return __hip_atomic_fetch_add(p, v, __ATOMIC_RELAXED, __HIP_MEMORY_SCOPE_AGENT); }
__device__ __forceinline__ unsigned xb_xcc_id() { return (unsigned)__builtin_amdgcn_s_getreg((3 << 11) | 20) & 0xFu; }
#define XB_SPIN(cond, bar) do { unsigned _sp = 0; while (cond) { __builtin_amdgcn_s_sleep(1); \
    if ((++_sp & 255u) == 0u) { if (xb_ld(&(bar)[XB_TMO])) break; if (_sp > XB_SPIN_CAP) { atomicAdd(&(bar)[XB_TMO], 1u); break; } } } } while (0)

struct XcdBarrier {
    unsigned* bar; unsigned x;
    volatile LAS unsigned* st;
};

__device__ __forceinline__ XcdBarrier xcd_barrier_post(unsigned* bar, volatile LAS unsigned* st) {
    XcdBarrier b; b.bar = bar; b.x = xb_xcc_id(); b.st = st;
    if (threadIdx.x == 0) (void)xb_add(&bar[XB_XCNT(b.x)], 1u);
    return b;
}
__device__ __forceinline__ void xcd_barrier_complete(unsigned* bar, unsigned x, unsigned& nloc, unsigned& nx) {
    const unsigned G = gridDim.x * gridDim.y * gridDim.z;
    unsigned sum, cnt, mine, sp = 0u;
    for (;;) {
        sum = 0u; cnt = 0u; mine = 0u;
#pragma unroll
        for (unsigned j = 0; j < 16; ++j) { const unsigned c = xb_ld(&bar[XB_XCNT(j)]); sum += c; cnt += (c > 0u) ? 1u : 0u; mine = (j == x) ? c : mine; }
        if (sum == G) break;
        __builtin_amdgcn_s_sleep(1);
        if ((++sp & 255u) == 0u) { if (xb_ld(&bar[XB_TMO])) break; if (sp > XB_SPIN_CAP) { atomicAdd(&bar[XB_TMO], 1u); break; } }
    }
    nloc = mine > 0u ? mine : 1u; nx = cnt > 0u ? cnt : 1u;
}

__device__ __forceinline__ void xcd_barrier(const XcdBarrier& b) {
    asm volatile("s_waitcnt vmcnt(0)" ::: "memory");
    __syncthreads();
    if (threadIdx.x == 0) {
        unsigned* bar = b.bar;
        __builtin_amdgcn_s_waitcnt(0);
        unsigned nloc = b.st[0], nx = b.st[1];
        if (nloc == 0u) { xcd_barrier_complete(bar, b.x, nloc, nx); b.st[0] = nloc; b.st[1] = nx; }
        const unsigned old = xb_add(&bar[XB_XSUB(b.x)], 1u);
        const unsigned gen = old / nloc;
        if (old + 1u == (gen + 1u) * nloc) {
            __builtin_amdgcn_fence(__ATOMIC_RELEASE, "agent");
            asm volatile("s_waitcnt vmcnt(0)" ::: "memory");
            const unsigned og = xb_add(&bar[XB_TOP], 1u);
            const unsigned tg = og / nx;
            if (og + 1u == (tg + 1u) * nx) xb_add(&bar[XB_TOPGEN], 1u);
            else XB_SPIN(xb_ld(&bar[XB_TOPGEN]) == tg, bar);
            __builtin_amdgcn_fence(__ATOMIC_ACQUIRE, "agent");
            xb_add(&bar[XB_XGEN(b.x)], 1u);
            asm volatile("s_waitcnt vmcnt(0)" ::: "memory");
        } else {
            XB_SPIN(xb_ld(&bar[XB_XGEN(b.x)]) == gen, bar);
            __builtin_amdgcn_fence(__ATOMIC_ACQUIRE, "agent");
            asm volatile("s_waitcnt vmcnt(0)" ::: "memory");
        }
    }
    __syncthreads();
}

struct Params {
    const float *x, *meta, *rel_table, *ln_attn_g, *ln_ffn_g, *w_in_a, *w_o_a, *qn_a, *kn_a, *kv_norm_g, *w_kv_b, *kn_b, *w_q_b, *qn_b,
                *lam_q1, *lam_k1, *lam_q2, *lam_k2, *subln_b, *w_o_b, *w_up, *conv_w, *conv_b, *w_down;
    float* out; unsigned char* ws; int ph_lo, ph_hi;
};
struct Frame {
    LAS unsigned char* lds;
    volatile LAS unsigned* MISC;
    gu32* ctl;
    int tid, lane, wave, G;
};
__device__ __forceinline__ float wave_sum(float v) {
#pragma unroll
    for (int o = 1; o < 64; o <<= 1) v += __shfl_xor(v, o);
    return v;
}
__device__ __forceinline__ int drow(int mode, int n) {
    if (mode == 1) { const int v = n >= DFF ? 1 : 0, f = n - v * DFF; return 256 * (f >> 7) + 128 * v + (f & 127); }
    if (mode == 2 || (mode == 3 && n < 1024)) { const int m = n >> 9, h = (n >> 6) & 7, d = n & 63, vh = 2 * h + m; return (mode == 3 ? 1024 : 0) + 256 * (vh >> 2) + 128 * (d >> 5) + 32 * (vh & 3) + (d & 31); }
    if (mode == 3) return 1024 + n;
    return n;
}
constexpr int TR_SCR = 2 * 64 * 33 * 4 + 512;
__device__ __forceinline__ void p0_transpose_item(const float* W, int K, int N, bf16* WT, const float* gain, int mode, LAS float* scr, int item, int lane) {
    const int nblk = (N + 63) / 64, kb = item / nblk, nb = item % nblk, k0 = 64 * kb, n0 = 64 * nb;
    const int c4 = 4 * (lane & 7), kq = lane >> 3;
    f32x4 v[2][8];
#pragma unroll
    for (int h = 0; h < 2; ++h) { const bool nok = n0 + 32 * h + c4 < N;
#pragma unroll
        for (int i = 0; i < 8; ++i) { const int kk = kq + 8 * i; v[h][i] = (f32x4){0.f, 0.f, 0.f, 0.f}; if (nok) v[h][i] = *(const f32x4*)(W + (size_t)(k0 + kk) * N + n0 + 32 * h + c4); } }
#pragma unroll
    for (int h = 0; h < 2; ++h)
#pragma unroll
        for (int i = 0; i < 8; ++i) { const int kk = kq + 8 * i; const float g = gain ? gain[k0 + kk] : 1.f; LAS float* d = scr + h * (64 * 33) + kk * 33 + c4; d[0] = v[h][i][0] * g; d[1] = v[h][i][1] * g; d[2] = v[h][i][2] * g; d[3] = v[h][i][3] * g; }
    LDS_WAIT(); asm volatile("" ::: "memory");
    const int c = lane & 7;
#pragma unroll
    for (int h = 0; h < 2; ++h)
#pragma unroll
        for (int j = 0; j < 4; ++j) { const int n = (lane >> 3) + 8 * j; const LAS float* sp = scr + h * (64 * 33) + (8 * c) * 33 + n;
            v4u o; o.x = pk2(sp[0 * 33], sp[1 * 33]); o.y = pk2(sp[2 * 33], sp[3 * 33]); o.z = pk2(sp[4 * 33], sp[5 * 33]); o.w = pk2(sp[6 * 33], sp[7 * 33]);
            if (n0 + 32 * h + n < N) *(GAS v4u*)(WT + (size_t)drow(mode, n0 + 32 * h + n) * K + k0 + 8 * c) = o; }
    LDS_WAIT(); asm volatile("" ::: "memory");
}
__device__ __forceinline__ int rel_bucket(int rel) {
    const int n = rel < 0 ? -rel : rel;
    int b = n < 8 ? n : n < 12 ? 8 : n < 16 ? 9 : n < 23 ? 10 : n < 32 ? 11 : n < 46 ? 12 : n < 64 ? 13 : n < 91 ? 14 : 15;
    return b + (rel > 0 ? 16 : 0);
}
__device__ __forceinline__ void norm_row_to_bf16(const float* xrow, bf16* orow, int lane) {
    const GAS f32x4* xr = (const GAS f32x4*)xrow + lane;
    f32x4 v[4]; float s = 0.f;
#pragma unroll
    for (int j = 0; j < 4; ++j) { v[j] = xr[64 * j]; s += (v[j].x * v[j].x + v[j].y * v[j].y) + (v[j].z * v[j].z + v[j].w * v[j].w); }
    const float rstd = 1.f / sqrtf(wave_sum(s) * (1.f / DM) + EPS);
    GAS unsigned long long* o8 = (GAS unsigned long long*)orow + lane;
#pragma unroll
    for (int j = 0; j < 4; ++j) o8[64 * j] = (unsigned long long)pk2(v[j].x * rstd, v[j].y * rstd) | ((unsigned long long)pk2(v[j].z * rstd, v[j].w * rstd) << 32);
}
__device__ __forceinline__ void norm_phase(Frame& F, const float* src_real, const float* src_meta, bf16* dst) {
    const int gw = blockIdx.x * NWAVES + F.wave, NGW = F.G * NWAVES;
    for (int r = gw; r < NVALID; r += 2 * NGW) {
        const int r2 = r + NGW; const bool has2 = r2 < NVALID; const int rb = has2 ? r2 : r;
        const float* sa = r < NREAL ? src_real + (size_t)r * DM : src_meta + (size_t)(r - NREAL) * DM;
        const float* sb = rb < NREAL ? src_real + (size_t)rb * DM : src_meta + (size_t)(rb - NREAL) * DM;
        const GAS f32x4* xa = (const GAS f32x4*)sa + F.lane; const GAS f32x4* xb = (const GAS f32x4*)sb + F.lane;
        f32x4 va[4], vb[4]; float s0 = 0.f, s1 = 0.f;
#pragma unroll
        for (int j = 0; j < 4; ++j) { va[j] = xa[64 * j]; vb[j] = xb[64 * j]; }
#pragma unroll
        for (int j = 0; j < 4; ++j) { s0 += (va[j].x * va[j].x + va[j].y * va[j].y) + (va[j].z * va[j].z + va[j].w * va[j].w); s1 += (vb[j].x * vb[j].x + vb[j].y * vb[j].y) + (vb[j].z * vb[j].z + vb[j].w * vb[j].w); }
        const float ra = 1.f / sqrtf(wave_sum(s0) * (1.f / DM) + EPS), rbs = 1.f / sqrtf(wave_sum(s1) * (1.f / DM) + EPS);
        GAS unsigned long long* oa = (GAS unsigned long long*)(dst + (size_t)r * DM) + F.lane; GAS unsigned long long* ob = (GAS unsigned long long*)(dst + (size_t)rb * DM) + F.lane;
#pragma unroll
        for (int j = 0; j < 4; ++j) { oa[64 * j] = (unsigned long long)pk2(va[j].x * ra, va[j].y * ra) | ((unsigned long long)pk2(va[j].z * ra, va[j].w * ra) << 32);
            if (has2) ob[64 * j] = (unsigned long long)pk2(vb[j].x * rbs, vb[j].y * rbs) | ((unsigned long long)pk2(vb[j].z * rbs, vb[j].w * rbs) << 32); }
    }
}
__device__ __forceinline__ void convert_l1_weights(Frame& F, const Params& P, int gw, int NGW) {
    LAS float* scr = (LAS float*)(F.lds + F.wave * TR_SCR);
    unsigned char* ws = P.ws;
    constexpr int I_O = 16 * 16, I_UP = 16 * 88, I_DN = 44 * 16, I_Q = 16 * 16, I_KV = 16 * 32;
    constexpr int NITEMS = I_DN + I_Q + I_KV + I_O + I_UP + I_DN;
    for (int it = gw; it < NITEMS; it += NGW) {
        int r = it;
        if (r < I_DN) { p0_transpose_item(P.w_down, DFF, DM, (bf16*)(ws + WS_WDN0), nullptr, 0, scr, r, F.lane); continue; } r -= I_DN;
        if (r < I_Q)  { p0_transpose_item(P.w_q_b, DM, DM, (bf16*)(ws + WS_WKVQ), P.ln_attn_g + DM, 2, scr, r, F.lane); continue; } r -= I_Q;
        if (r < I_KV) { p0_transpose_item(P.w_kv_b, DM, 2048, (bf16*)(ws + WS_WKVQ), P.kv_norm_g, 3, scr, r, F.lane); continue; } r -= I_KV;
        if (r < I_O)  { p0_transpose_item(P.w_o_b, DM, DM, (bf16*)(ws + WS_WOB), nullptr, 0, scr, r, F.lane); continue; } r -= I_O;
        if (r < I_UP) { p0_transpose_item(P.w_up + (size_t)DM * 2 * DFF, DM, 2 * DFF, (bf16*)(ws + WS_WUP1), P.ln_ffn_g + DM, 1, scr, r, F.lane); continue; } r -= I_UP;
        p0_transpose_item(P.w_down + (size_t)DFF * DM, DFF, DM, (bf16*)(ws + WS_WDN1), nullptr, 0, scr, r, F.lane);
    }
}
__device__ __forceinline__ void p0_prologue(Frame& F, const Params& P) {
    LAS float* scr = (LAS float*)(F.lds + F.wave * TR_SCR);
    unsigned char* ws = P.ws;
    const int gw = blockIdx.x * NWAVES + F.wave, NGW = F.G * NWAVES;
    constexpr int I_IN = 16 * 34, I_O = 16 * 16, I_UP = 16 * 88;
    constexpr int NITEMS = I_IN + I_O + I_UP;
    for (int it = gw; it < NITEMS; it += NGW) {
        int r = it;
        if (r < I_IN) { p0_transpose_item(P.w_in_a, DM, 2120, (bf16*)(ws + WS_WIN), P.ln_attn_g, 0, scr, r, F.lane); continue; } r -= I_IN;
        if (r < I_O)  { p0_transpose_item(P.w_o_a, DM, DM, (bf16*)(ws + WS_WOA), nullptr, 0, scr, r, F.lane); continue; } r -= I_O;
        p0_transpose_item(P.w_up, DM, 2 * DFF, (bf16*)(ws + WS_WUP0), P.ln_ffn_g, 1, scr, r, F.lane);
    }
    { GAS v4u* z = (GAS v4u*)(ws + WS_WIN + (size_t)2120 * DM * 2); const int nz = 184 * DM * 2 / 16;
      for (int i = blockIdx.x * NWAVES * 64 + F.tid; i < nz; i += F.G * NWAVES * 64) z[i] = (v4u){0u, 0u, 0u, 0u}; }
    if (blockIdx.x == 0) {
        float* bt = (float*)(ws + WS_BT);
        for (int i = F.tid; i < 8 * BT_N; i += NWAVES * 64) { const int h = i / BT_N, rel = i % BT_N - BT_OFF; bt[i] = P.rel_table[rel_bucket(rel) * 8 + h] * L2E; }
        if (F.wave == 0) { const float a = wave_sum(P.lam_q1[F.lane] * P.lam_k1[F.lane]), b = wave_sum(P.lam_q2[F.lane] * P.lam_k2[F.lane]);
            const float lam_init = 0.8f - 0.6f * expf(-0.3f); if (F.lane == 0) *(float*)(ws + WS_LAM) = expf(a) - expf(b) + lam_init; }
    }
    norm_phase(F, P.x, P.meta, (bf16*)(ws + WS_X0));
}
template <int HL> __device__ __forceinline__ void headnorm_phase(Frame& F, bf16* buf, int ld, int qcol, int nq, int kcol, int nk, const float* gq, const float* gk, float qscale) {
    const int gw = blockIdx.x * NWAVES + F.wave, NGW = F.G * NWAVES, nch = nq + nk;
    for (int r = gw; r < NVALID; r += NGW) {
        bf16* row = buf + (size_t)r * ld;
        for (int c0 = 0; c0 < nch; c0 += 64) {
            const int c = c0 + F.lane; const bool ok = c < nch; const int cc = ok ? c : nch - 1;
            const bool isq = cc < nq; bf16* p = row + (isq ? qcol + cc * 8 : kcol + (cc - nq) * 8);
            const v4u w = *(const GAS v4u*)p;
            float v[8]; v[0] = bf2f(w.x & 0xffff); v[1] = bf2f(w.x >> 16); v[2] = bf2f(w.y & 0xffff); v[3] = bf2f(w.y >> 16); v[4] = bf2f(w.z & 0xffff); v[5] = bf2f(w.z >> 16); v[6] = bf2f(w.w & 0xffff); v[7] = bf2f(w.w >> 16);
            float ss = 0.f;
#pragma unroll
            for (int e = 0; e < 8; ++e) ss += v[e] * v[e];
#pragma unroll
            for (int o = 1; o < HL; o <<= 1) ss += __shfl_xor(ss, o);
            const float rstd = 1.f / sqrtf(ss * (1.f / (HL * 8)) + EPS) * (isq ? qscale : 1.f);
            const float* g = (isq ? gq : gk) + ((isq ? cc : cc - nq) % HL) * 8;
            v4u o; o.x = pk2(v[0] * rstd * g[0], v[1] * rstd * g[1]); o.y = pk2(v[2] * rstd * g[2], v[3] * rstd * g[3]); o.z = pk2(v[4] * rstd * g[4], v[5] * rstd * g[5]); o.w = pk2(v[6] * rstd * g[6], v[7] * rstd * g[7]);
            if (ok) *(GAS v4u*)p = o;
        }
    }
}
constexpr int IX_ROW = 2080;
__device__ __forceinline__ unsigned key16x2(unsigned w) { const unsigned m = (w >> 15) & 0x00010001u; return w ^ (0x80008000u | (m * 0x7FFFu)); }
__device__ __forceinline__ void radix_find_pair(LAS unsigned* hist, const int (&need)[2], int (&bin)[2], int (&above)[2], int lane) {
    const v4u h4 = *(LAS v4u*)(hist + 4 * lane);
    const unsigned s = h4.x + h4.y + h4.z + h4.w; unsigned incl = s;
#pragma unroll
    for (int o = 1; o < 64; o <<= 1) { const unsigned t = (unsigned)__shfl_down((int)incl, o); incl += (lane + o < 64) ? t : 0u; }
#pragma unroll
    for (int h = 0; h < 2; ++h) {
        const int ih = (int)((incl >> (16 * h)) & 0xFFFFu), sh = (int)((s >> (16 * h)) & 0xFFFFu);
        const unsigned long long ball = __ballot(ih >= need[h]);
        const int L = 63 - __builtin_clzll(ball | 1ull);
        int cum = __builtin_amdgcn_readlane(ih, L) - __builtin_amdgcn_readlane(sh, L);
        const int c3 = __builtin_amdgcn_readlane((int)((h4.w >> (16 * h)) & 0xFFFFu), L), c2 = __builtin_amdgcn_readlane((int)((h4.z >> (16 * h)) & 0xFFFFu), L), c1 = __builtin_amdgcn_readlane((int)((h4.y >> (16 * h)) & 0xFFFFu), L);
        int b = 4 * L + 3;
        if (cum + c3 < need[h]) { cum += c3; b = 4 * L + 2; if (cum + c2 < need[h]) { cum += c2; b = 4 * L + 1; if (cum + c1 < need[h]) { cum += c1; b = 4 * L; } } }
        above[h] = cum; bin[h] = b;
    }
}
__device__ __forceinline__ void select4(const LAS unsigned short* srow, unsigned long long* mrow, int qt, LAS unsigned* hist, int lane) {
    const int nit = qt + 2;
    if (qt <= 2) { unsigned long long w = 0ull; if (lane == 0) w = 0xFFFFull; else if (lane < nit) w = ~0ull;
        if (lane < MASKW) {
#pragma unroll
            for (int r = 0; r < 4; ++r) mrow[r * MASKW + lane] = w; }
        return; }
    const int nw = (80 + 64 * qt) >> 1;
    int D0[4], D1[4], need[4] = {256, 256, 256, 256};
#pragma unroll
    for (int pass = 0; pass < 2; ++pass) {
        *(LAS v4u*)(hist + 4 * lane) = (v4u){0u, 0u, 0u, 0u}; *(LAS v4u*)(hist + 256 + 4 * lane) = (v4u){0u, 0u, 0u, 0u};
        asm volatile("s_waitcnt lgkmcnt(0)" ::: "memory");
        for (int idx = lane; idx < nw; idx += 64) {
            unsigned u[4];
#pragma unroll
            for (int r = 0; r < 4; ++r) u[r] = key16x2(((const LAS unsigned*)(srow + r * IX_ROW))[idx]);
#pragma unroll
            for (int r = 0; r < 4; ++r) { LAS unsigned* H = hist + (r >> 1) * 256; const unsigned inc = (r & 1) ? 65536u : 1u; const unsigned k0 = u[r] & 0xFFFFu, k1 = u[r] >> 16;
                if (pass == 0) { __hip_atomic_fetch_add(H + (k0 >> 8), inc, __ATOMIC_RELAXED, __HIP_MEMORY_SCOPE_WORKGROUP); __hip_atomic_fetch_add(H + (k1 >> 8), inc, __ATOMIC_RELAXED, __HIP_MEMORY_SCOPE_WORKGROUP); }
                else { if ((int)(k0 >> 8) == D0[r]) __hip_atomic_fetch_add(H + (k0 & 255u), inc, __ATOMIC_RELAXED, __HIP_MEMORY_SCOPE_WORKGROUP);
                       if ((int)(k1 >> 8) == D0[r]) __hip_atomic_fetch_add(H + (k1 & 255u), inc, __ATOMIC_RELAXED, __HIP_MEMORY_SCOPE_WORKGROUP); } }
        }
        asm volatile("s_waitcnt lgkmcnt(0)" ::: "memory");
#pragma unroll
        for (int pr = 0; pr < 2; ++pr) { const int nd[2] = {need[2 * pr], need[2 * pr + 1]}; int bn[2], ab[2];
            radix_find_pair(hist + pr * 256, nd, bn, ab, lane);
            if (pass == 0) { D0[2 * pr] = bn[0]; D0[2 * pr + 1] = bn[1]; } else { D1[2 * pr] = bn[0]; D1[2 * pr + 1] = bn[1]; }
            need[2 * pr] -= ab[0]; need[2 * pr + 1] -= ab[1]; }
        asm volatile("s_waitcnt lgkmcnt(0)" ::: "memory");
    }
    unsigned T[4]; unsigned long long myword[4] = {0ull, 0ull, 0ull, 0ull};
#pragma unroll
    for (int r = 0; r < 4; ++r) T[r] = ((unsigned)D0[r] << 8) | (unsigned)D1[r];
    const unsigned long long below = (1ull << lane) - 1ull;
    for (int i = 0; i < nit; ++i) {
        const bool ok = (i > 0) || (lane < 16); const int e = (i == 0) ? (lane & 15) : 16 + 64 * (i - 1) + lane;
        unsigned u[4];
#pragma unroll
        for (int r = 0; r < 4; ++r) u[r] = key16x2(srow[r * IX_ROW + e]) & 0xFFFFu;
#pragma unroll
        for (int r = 0; r < 4; ++r) {
            const unsigned long long gtb = __ballot(ok && u[r] > T[r]), eqb = __ballot(ok && u[r] == T[r]);
            const int ne = __popcll(eqb); unsigned long long sel = eqb;
            if (ne > need[r]) sel = __ballot(ok && (u[r] == T[r]) && (__popcll(eqb & below) < need[r]));
            need[r] -= __popcll(sel);
            if (lane == i) myword[r] = gtb | sel;
        }
    }
    if (lane < MASKW) {
#pragma unroll
        for (int r = 0; r < 4; ++r) mrow[r * MASKW + lane] = myword[r]; }
}
constexpr int IX_SROWS = 8 * 4 * IX_ROW * 2;
constexpr int IX_STG = 64 * 144;
static_assert(IX_SROWS + 2 * IX_STG <= LDSCTL_OFF && 8 * 2048 <= 2 * IX_STG, "indexer LDS");
__device__ __forceinline__ void idxsel_sub(const bf16* PROJ, unsigned long long* MASK, LAS unsigned char* lds, int b, int qt, int q0, int wave, int lane, int tid) {
    const int j = lane & 31, hi = lane >> 5;
    LAS _Float16* srow = (LAS _Float16*)(lds + wave * (4 * IX_ROW * 2)); LAS unsigned* hist = (LAS unsigned*)(lds + IX_SROWS + wave * 2048);
    LAS unsigned char* stg = lds + IX_SROWS;
    __syncthreads();
    if (qt >= 3) {
        bf16x8 af[4];
        { const bf16* ap = PROJ + (size_t)(q0 + (j >> 3)) * PROJ_LD + 1536 + (j & 7) * 64 + hi * 8;
#pragma unroll
          for (int ks = 0; ks < 4; ++ks) af[ks] = *(const bf16x8*)(ap + ks * 16); }
        float w[16];
#pragma unroll
        for (int r = 0; r < 16; ++r) w[r] = bf2f(PROJ[(size_t)(q0 + (r >> 2)) * PROJ_LD + 2112 + (r & 3) + 4 * hi]) * 0.044194173824159216f;
        const int ng = qt + 2;
        LAS _Float16* sw = srow + (2 * hi) * IX_ROW;
        const int sslot = tid >> 3, spiece = tid & 7;
        bf16x8 sreg;
#define IX_GLOAD(g_) do { const int krow_ = (g_) == 0 ? NREAL + (sslot < 16 ? sslot : 15) : b * SEQ + 64 * ((g_) - 1) + sslot; sreg = *(const bf16x8*)(PROJ + (size_t)krow_ * PROJ_LD + 2048 + spiece * 8); } while (0)
#define IX_GWRITE(buf_) do { *(LAS bf16x8*)(stg + (buf_) * IX_STG + sslot * 144 + spiece * 16) = sreg; } while (0)
#define IX_COMP(buf_, g_, blk_) do { const LAS unsigned char* bp_ = stg + (buf_) * IX_STG + (32 * (blk_) + j) * 144 + hi * 16; f32x16 acc = {}; \
            _Pragma("unroll") for (int ks = 0; ks < 4; ++ks) { const bf16x8 bf_ = *(const LAS bf16x8*)(bp_ + ks * 32); acc = __builtin_amdgcn_mfma_f32_32x32x16_bf16(af[ks], bf_, acc, 0, 0, 0); } \
            float s_[4]; _Pragma("unroll") for (int q = 0; q < 4; ++q) { float t = 0.f; _Pragma("unroll") for (int i = 0; i < 4; ++i) t += w[4 * q + i] * fmaxf(acc[4 * q + i], 0.f); \
                auto rr_ = __builtin_amdgcn_permlane32_swap(__float_as_uint(t), __float_as_uint(t), false, false); s_[q] = __uint_as_float(rr_[0]) + __uint_as_float(rr_[1]); } \
            float s0 = hi ? s_[2] : s_[0], s1 = hi ? s_[3] : s_[1]; s0 = (s0 == 0.f) ? 0.f : s0; s1 = (s1 == 0.f) ? 0.f : s1; \
            const int col = (g_) == 0 ? j : 16 + 64 * ((g_) - 1) + 32 * (blk_) + j; \
            if ((g_) > 0 || j < 16) { sw[col] = (_Float16)s0; sw[IX_ROW + col] = (_Float16)s1; } } while (0)
        IX_GLOAD(0); IX_GWRITE(0); __syncthreads();
        for (int g = 0; g < ng; g += 2) {
            if (g + 1 < ng) IX_GLOAD(g + 1);
            IX_COMP(0, g, 0); if (g > 0) IX_COMP(0, g, 1);
            if (g + 1 < ng) IX_GWRITE(1);
            __syncthreads();
            if (g + 1 < ng) {
                if (g + 2 < ng) IX_GLOAD(g + 2);
                IX_COMP(1, g + 1, 0); IX_COMP(1, g + 1, 1);
                if (g + 2 < ng) IX_GWRITE(0);
                __syncthreads();
            }
        }
#undef IX_GLOAD
#undef IX_GWRITE
#undef IX_COMP
        asm volatile("s_waitcnt lgkmcnt(0)" ::: "memory");
    }
    select4((const LAS unsigned short*)srow, MASK + (size_t)q0 * MASKW, qt, hist, lane);
}
__device__ __forceinline__ void idxsel_phase(Frame& F, const bf16* PROJ, unsigned long long* MASK) {
    if (blockIdx.x == 0 && F.tid < 16) MASK[(size_t)(NREAL + F.tid) * MASKW] = 0xFFFFull;
    for (int w = (int)blockIdx.x; w < 256; w += F.G) {
        const int b = w >> 5, p = w & 31, qt = p >> 1, half = p & 1;
        idxsel_sub(PROJ, MASK, F.lds, b, 31 - qt, b * SEQ + 64 * (31 - qt) + 32 * half + 4 * F.wave, F.wave, F.lane, F.tid);
        idxsel_sub(PROJ, MASK, F.lds, b, qt, b * SEQ + 64 * qt + 32 * half + 4 * F.wave, F.wave, F.lane, F.tid);
    }
}
__device__ __forceinline__ float meta_rstd(Frame& F, const float* psm) {
    const int row = F.tid >> 5, j = F.tid & 31; float t = 0.f;
#pragma unroll
    for (int k = 0; k < 8; ++k) t += psm[row * 256 + j + 32 * k];
#pragma unroll
    for (int o = 1; o < 32; o <<= 1) t += __shfl_xor(t, o);
    return __builtin_amdgcn_rsqf(t * (1.f / 1024.f) + 1e-6f);
}
__device__ __forceinline__ float meta_gemm(Frame& F, const bf16* A16, int lda, const bf16* Bt, int K, int b0r, int b1r) {
    const int fr = F.lane & 15, fq = F.lane >> 4, kper = K >> 3, k0 = F.wave * kper;
    const bf16* ap = A16 + (size_t)fr * lda + k0 + 8 * fq;
    const bf16* bp0 = Bt + (size_t)b0r * K + k0 + 8 * fq; const bf16* bp1 = Bt + (size_t)b1r * K + k0 + 8 * fq;
    f32x4 acc0 = {0.f, 0.f, 0.f, 0.f}, acc1 = {0.f, 0.f, 0.f, 0.f};
    for (int k = 0; k < kper; k += 32) { const bf16x8 a = *(const bf16x8*)(ap + k), b0 = *(const bf16x8*)(bp0 + k), b1 = *(const bf16x8*)(bp1 + k);
        acc0 = __builtin_amdgcn_mfma_f32_16x16x32_bf16(b0, a, acc0, 0, 0, 0); acc1 = __builtin_amdgcn_mfma_f32_16x16x32_bf16(b1, a, acc1, 0, 0, 0); }
    LAS float* part = (LAS float*)F.lds;
    LAS float* pp = part + F.wave * 512 + fr * 32 + 4 * fq;
    *(LAS f32x4*)pp = acc0; *(LAS f32x4*)(pp + 16) = acc1;
    __syncthreads();
    float v = 0.f;
#pragma unroll
    for (int w = 0; w < 8; ++w) v += part[w * 512 + F.tid];
    __syncthreads();
    return v;
}
__device__ __forceinline__ void meta_store_bf16(Frame& F, const bf16* A16, const bf16* Bt, bf16* O, int ldo, int ncols, int per, const float* rs) {
    const int c0 = per * (int)blockIdx.x, fr = F.lane & 15;
    if (c0 >= ncols) return;
    const int n0 = c0 + fr; const float v = meta_gemm(F, A16, DM, Bt, DM, (fr < per && n0 < ncols) ? n0 : 0, 0);
    const int row = F.tid >> 5, col = F.tid & 31, n = c0 + col;
    const float sc = rs ? meta_rstd(F, rs) : 1.f;
    if (col < per && n < ncols) O[(size_t)(NREAL + row) * ldo + n] = (bf16)f2bf(v * sc);
}
__device__ __forceinline__ void meta_kvq(Frame& F, const bf16* A16, const bf16* Bt, bf16* KVQ, const float* rs, const float* gq, const float* gk, float qscale) {
    const int w = (int)blockIdx.x, fr = F.lane & 15;
    if (w >= 64) return;
    const float r = meta_rstd(F, rs);
    const int row = F.tid >> 5, j = F.tid & 31;
    if (w < 32) {
        const int vh = w & 15, base = (w >> 4) * 1024 + 256 * (vh >> 2) + 32 * (vh & 3);
        const float v0 = meta_gemm(F, A16, DM, Bt, DM, base + fr, base + 16 + fr) * r;
        const float v1 = meta_gemm(F, A16, DM, Bt, DM, base + 128 + fr, base + 128 + 16 + fr) * r;
        float ss = v0 * v0 + v1 * v1;
#pragma unroll
        for (int o = 1; o < 32; o <<= 1) ss += __shfl_xor(ss, o);
        const float rh = __builtin_amdgcn_rsqf(ss * (1.f / 64.f) + 1e-6f) * (w < 16 ? qscale : 1.f);
        const float* g = w < 16 ? gq : gk;
        bf16* o = KVQ + (size_t)(NREAL + row) * KVQ_LD + (w >> 4) * 1024 + vh * 64;
        o[j] = (bf16)f2bf(v0 * rh * g[j]); o[32 + j] = (bf16)f2bf(v1 * rh * g[32 + j]);
    } else {
        const int n0 = 2048 + 32 * (w - 32);
        const float v = meta_gemm(F, A16, DM, Bt, DM, n0 + fr, n0 + 16 + fr) * r;
        KVQ[(size_t)(NREAL + row) * KVQ_LD + n0 + j] = (bf16)f2bf(v);
    }
}
__device__ __forceinline__ void knorm0_phase(Frame& F, bf16* PROJ, const float* gk) {
    const int gw = blockIdx.x * NWAVES + F.wave, NGW = F.G * NWAVES, half = F.lane >> 5, c = F.lane & 31;
    const f32x4 g0 = *(const f32x4*)(gk + (c & 15) * 8), g1 = *(const f32x4*)(gk + (c & 15) * 8 + 4);
    for (int r2 = gw; r2 < NVALID / 2; r2 += NGW) {
        bf16* p = PROJ + (size_t)(2 * r2 + half) * PROJ_LD + 1024 + c * 8;
        const v4u w = *(const GAS v4u*)p;
        float v[8]; v[0] = bf2f(w.x & 0xffff); v[1] = bf2f(w.x >> 16); v[2] = bf2f(w.y & 0xffff); v[3] = bf2f(w.y >> 16); v[4] = bf2f(w.z & 0xffff); v[5] = bf2f(w.z >> 16); v[6] = bf2f(w.w & 0xffff); v[7] = bf2f(w.w >> 16);
        float ss = 0.f;
#pragma unroll
        for (int e = 0; e < 8; ++e) ss += v[e] * v[e];
#pragma unroll
        for (int o = 1; o < 16; o <<= 1) ss += __shfl_xor(ss, o);
        const float rstd = __builtin_amdgcn_rsqf(ss * (1.f / 128.f) + 1e-6f);
        v4u o; o.x = pk2(v[0] * rstd * g0[0], v[1] * rstd * g0[1]); o.y = pk2(v[2] * rstd * g0[2], v[3] * rstd * g0[3]); o.z = pk2(v[4] * rstd * g1[0], v[5] * rstd * g1[1]); o.w = pk2(v[6] * rstd * g1[2], v[7] * rstd * g1[3]);
        *(GAS v4u*)p = o;
    }
}
__device__ __forceinline__ void meta_resid(Frame& F, const bf16* A16, int K, const bf16* Bt, const float* base_f32, const bf16* base_bf, bf16* xb, float* rowss) {
    const int c0 = 4 * (int)blockIdx.x, fr = F.lane & 15;
    const float v = meta_gemm(F, A16, K, Bt, K, fr < 4 ? c0 + fr : 0, 0);
    const int row = F.tid >> 5, col = F.tid & 31;
    float o = 0.f;
    if (col < 4) { o = (base_f32 ? base_f32[row * DM + c0 + col] : bf2f(base_bf[(size_t)(NREAL + row) * DM + c0 + col])) + v; xb[(size_t)(NREAL + row) * DM + c0 + col] = (bf16)f2bf(o); }
    if (rowss) { float ss = o * o; ss += __shfl_xor(ss, 1); ss += __shfl_xor(ss, 2); if (col == 0) rowss[row * 256 + (int)blockIdx.x] = ss; }
}
__device__ __forceinline__ void meta_upconv(Frame& F, const bf16* A16, const bf16* Bt, bf16* G, float* UH, const float* cw, const float* cb, const float* rs, int f0) {
    const int fr = F.lane & 15, ff = f0 + (fr < 11 ? fr : 0), gr = 256 * (ff >> 7) + (ff & 127);
    const float v = meta_gemm(F, A16, DM, Bt, DM, gr, gr + 128);
    LAS float* U = (LAS float*)F.lds;
    U[F.tid] = v * meta_rstd(F, rs);
    __syncthreads();
    const int row = F.tid >> 5, j = F.tid & 31;
    if (j < 11) { const int f = f0 + j;
        float x[2];
#pragma unroll
        for (int gv = 0; gv < 2; ++gv) { const int c = gv * DFF + f, jj = j + 16 * gv;
            const float u0 = U[row * 32 + jj], u1 = row >= 1 ? U[(row - 1) * 32 + jj] : 0.f, u2 = row >= 2 ? U[(row - 2) * 32 + jj] : 0.f;
            x[gv] = cb[c] + cw[c] * u2 + cw[5632 + c] * u1 + cw[11264 + c] * u0;
            if (row >= 14) UH[(size_t)(256 * 4 + 2 + (row - 14)) * 5632 + c] = u0; }
        const float s = 1.f / (1.f + exp2f(-x[0] * L2E));
        G[(size_t)(NREAL + row) * DFF + f] = (bf16)f2bf(x[0] * s * x[1]); }
    __syncthreads();
}
__device__ __forceinline__ void idxcols_gemm(Frame& F, const bf16* X, const bf16* Wt, bf16* PROJ) {
    constexpr int BROW = 2048 + 16;
    LAS unsigned char* bl = F.lds;
    { const GAS v4u* src = (const GAS v4u*)(Wt + (size_t)2048 * DM);
      for (int i = F.tid; i < 72 * 128; i += NWAVES * 64) *(LAS v4u*)(bl + (i >> 7) * BROW + (i & 127) * 16) = src[i]; }
    __syncthreads();
    const int fr = F.lane & 15, fq = F.lane >> 4, rt = F.wave & 3, cg = F.wave >> 2;
    const int row = 64 * (int)blockIdx.x + 16 * rt + fr;
    const bf16* ap = X + (size_t)row * DM + 8 * fq;
    const int nct = cg == 0 ? 3 : 2;
    const LAS unsigned char* bp[3];
#pragma unroll
    for (int c = 0; c < 3; ++c) { int n = 16 * (3 * cg + c) + fr; if (n > 71) n = 71; bp[c] = bl + n * BROW + 16 * fq; }
    f32x4 acc[3] = {{0.f, 0.f, 0.f, 0.f}, {0.f, 0.f, 0.f, 0.f}, {0.f, 0.f, 0.f, 0.f}};
#pragma unroll
    for (int h = 0; h < 2; ++h) {
        bf16x8 af[16];
#pragma unroll
        for (int i = 0; i < 16; ++i) af[i] = *(const bf16x8*)(ap + 512 * h + 32 * i);
#pragma unroll
        for (int i = 0; i < 16; ++i) {
#pragma unroll
            for (int c = 0; c < 3; ++c) if (c < nct) { const bf16x8 b = *(const LAS bf16x8*)(bp[c] + 2 * (512 * h + 32 * i)); acc[c] = __builtin_amdgcn_mfma_f32_16x16x32_bf16(b, af[i], acc[c], 0, 0, 0); } }
    }
#pragma unroll
    for (int c = 0; c < 3; ++c) if (c < nct) { const int col = 2048 + 16 * (3 * cg + c) + 4 * fq;
        if (col < PROJ_LD) { v2u w; w.x = cvtpk(acc[c][0], acc[c][1]); w.y = cvtpk(acc[c][2], acc[c][3]); *(GAS v2u*)(PROJ + (size_t)row * PROJ_LD + col) = w; } }
    __syncthreads();
}
__device__ __forceinline__ void fixup_panel(Frame& F, const float* UH, bf16* G, const float* cw, const float* cb, int pm) {
    LAS float* wl = (LAS float*)F.lds;
    for (int i = F.tid; i < 4 * 5632 / 4; i += NWAVES * 64) { const f32x4 v = i < 3 * 5632 / 4 ? *(const f32x4*)(cw + 4 * i) : *(const f32x4*)(cb + 4 * i - 3 * 5632); *(LAS f32x4*)(wl + 4 * i) = v; }
    __syncthreads();
    for (int i = F.tid; i < 4 * (DFF / 4); i += NWAVES * 64) {
        const int f = (i % (DFF / 4)) * 4, blk = 4 * pm + i / (DFF / 4);
        const int pblk = (blk & 31) == 0 ? 256 : blk - 1;
        const float* hb = UH + (size_t)blk * 4 * 5632; const float* pb = UH + (size_t)pblk * 4 * 5632;
        f32x4 x0[2], x1[2];
#pragma unroll
        for (int gv = 0; gv < 2; ++gv) {
            const int c = gv * DFF + f;
            const f32x4 t2 = *(const f32x4*)(pb + 2 * 5632 + c), t3 = *(const f32x4*)(pb + 3 * 5632 + c);
            const f32x4 h0 = *(const f32x4*)(hb + c), h1 = *(const f32x4*)(hb + 5632 + c);
            const f32x4 w0 = *(const LAS f32x4*)(wl + c), w1 = *(const LAS f32x4*)(wl + 5632 + c), w2 = *(const LAS f32x4*)(wl + 11264 + c), bb = *(const LAS f32x4*)(wl + 16896 + c);
            x0[gv] = bb + w0 * t2 + w1 * t3 + w2 * h0; x1[gv] = bb + w0 * t3 + w1 * h0 + w2 * h1;
        }
        f32x4 o0, o1;
#pragma unroll
        for (int e = 0; e < 4; ++e) { const float s0 = __builtin_amdgcn_rcpf(1.f + __builtin_amdgcn_exp2f(-x0[0][e] * L2E)), s1 = __builtin_amdgcn_rcpf(1.f + __builtin_amdgcn_exp2f(-x1[0][e] * L2E));
            o0[e] = x0[0][e] * s0 * x0[1][e]; o1[e] = x1[0][e] * s1 * x1[1][e]; }
        v2u w; w.x = pk2(o0[0], o0[1]); w.y = pk2(o0[2], o0[3]); *(GAS v2u*)(G + (size_t)(blk * 64) * DFF + f) = w;
        w.x = pk2(o1[0], o1[1]); w.y = pk2(o1[2], o1[3]); *(GAS v2u*)(G + (size_t)(blk * 64 + 1) * DFF + f) = w;
    }
    asm volatile("s_waitcnt vmcnt(0)" ::: "memory");
    __syncthreads();
}

#define KSWZ(row, colB) ((row) * 256 + ((colB) ^ (((row) & 7) << 4)))
#define SBAR() __builtin_amdgcn_sched_barrier(0)
__device__ __forceinline__ int v_st(int k, int c) { const int kk = (k & ~0xC) | ((k & 4) << 1) | ((k & 8) >> 1); return ((kk >> 3) * 4 + (c >> 5)) * 512 + ((kk & 7) * 32 + (c & 31)) * 2; }
__device__ __forceinline__ int v_rd_base(int lane) { return ((lane & 3) << 3) | (((lane >> 2) & 3) << 6) | (((lane >> 4) & 1) << 5) | (((lane >> 5) & 1) << 8); }
constexpr int v_rd_off(int d0, int ks, int half) { return d0 * 512 + ks * 4096 + half * 2048; }
__device__ __forceinline__ int crow(int r, int hi) { return (r & 3) + 8 * (r >> 2) + 4 * hi; }
template <int KB, int ND0>
__device__ __forceinline__ void qkt(f32x16& p0, f32x16& p1, const LAS char* K_lds, int r32, int hi, const bf16x8* qr, int kmapoff, float cinit) {
#pragma unroll
    for (int r = 0; r < 16; ++r) { p0[r] = cinit; p1[r] = cinit; }
    const LAS char* kb[4];
#pragma unroll
    for (int dd = 0; dd < 4; ++dd) kb[dd] = K_lds + KB * SHM_K + KSWZ(r32, (dd * 16 + hi * 8) * 2) + kmapoff;
    if constexpr (ND0 == 4) {
        bf16x8 kf[8];
#pragma unroll
        for (int d0 = 0; d0 < 4; ++d0) { kf[2 * d0] = *reinterpret_cast<const LAS bf16x8*>(kb[d0]); kf[2 * d0 + 1] = *reinterpret_cast<const LAS bf16x8*>(kb[d0] + 32 * 256); }
        SBAR();
#pragma unroll
        for (int d0 = 0; d0 < 4; ++d0) { p0 = __builtin_amdgcn_mfma_f32_32x32x16_bf16(kf[2 * d0], qr[d0], p0, 0, 0, 0); p1 = __builtin_amdgcn_mfma_f32_32x32x16_bf16(kf[2 * d0 + 1], qr[d0], p1, 0, 0, 0); }
    } else {
#pragma unroll
    for (int d0 = 0; d0 < ND0; ++d0) { const LAS char* a = kb[d0 & 3] + (d0 >> 2) * 128;
        const bf16x8 b0 = *reinterpret_cast<const LAS bf16x8*>(a);
        const bf16x8 b1 = *reinterpret_cast<const LAS bf16x8*>(a + 32 * 256);
        p0 = __builtin_amdgcn_mfma_f32_32x32x16_bf16(b0, qr[d0], p0, 0, 0, 0);
        p1 = __builtin_amdgcn_mfma_f32_32x32x16_bf16(b1, qr[d0], p1, 0, 0, 0); }
    }
}
template <int VB>
__device__ __forceinline__ void pv_tile(f32x16* o, int vb0, bf16x8 pa0, bf16x8 pa1, bf16x8 pa2, bf16x8 pa3) {
#define TRRD(dst, off) asm volatile("ds_read_b64_tr_b16 %0, %1 offset:%2" : "=&v"(dst) : "v"(vb0), "i"(off) : "memory")
#define PV_D0(d0) do { s16x4 l0, l1, l2, l3, h0, h1, h2, h3; constexpr int b_ = VB * SHM_V + v_rd_off(d0, 0, 0);   \
        TRRD(l0, b_); TRRD(h0, b_ + 2048); TRRD(l1, b_ + 4096); TRRD(h1, b_ + 6144); TRRD(l2, b_ + 8192); TRRD(h2, b_ + 10240); TRRD(l3, b_ + 12288); TRRD(h3, b_ + 14336); \
        asm volatile("s_waitcnt lgkmcnt(0)" ::: "memory"); SBAR();   \
        o[d0] = __builtin_amdgcn_mfma_f32_32x32x16_bf16(pa0, (bf16x8){l0[0], l0[1], l0[2], l0[3], h0[0], h0[1], h0[2], h0[3]}, o[d0], 0, 0, 0);   \
        o[d0] = __builtin_amdgcn_mfma_f32_32x32x16_bf16(pa1, (bf16x8){l1[0], l1[1], l1[2], l1[3], h1[0], h1[1], h1[2], h1[3]}, o[d0], 0, 0, 0);   \
        o[d0] = __builtin_amdgcn_mfma_f32_32x32x16_bf16(pa2, (bf16x8){l2[0], l2[1], l2[2], l2[3], h2[0], h2[1], h2[2], h2[3]}, o[d0], 0, 0, 0);   \
        o[d0] = __builtin_amdgcn_mfma_f32_32x32x16_bf16(pa3, (bf16x8){l3[0], l3[1], l3[2], l3[3], h3[0], h3[1], h3[2], h3[3]}, o[d0], 0, 0, 0); } while (0)
    PV_D0(0); PV_D0(1); PV_D0(2); PV_D0(3);
#undef PV_D0
#undef TRRD
}
__device__ __forceinline__ float swap32f(float v) { auto rr = __builtin_amdgcn_permlane32_swap(__float_as_uint(v), __float_as_uint(v), false, false); return __uint_as_float(rr[1]); }
__device__ __forceinline__ float partialSM(f32x16& p0, f32x16& p1, float& m_reg) {
    float pmax = p0[0];
#pragma unroll
    for (int r = 1; r < 16; ++r) pmax = fmaxf(pmax, p0[r]);
#pragma unroll
    for (int r = 0; r < 16; ++r) pmax = fmaxf(pmax, p1[r]);
    { auto rr = __builtin_amdgcn_permlane32_swap(__float_as_uint(pmax), __float_as_uint(pmax), false, false);
      pmax = fmaxf(__uint_as_float(rr[0]), __uint_as_float(rr[1])); }
    const bool need = !__all(pmax - m_reg <= 8.f);
    const float mn = need ? fmaxf(m_reg, pmax) : m_reg; const float alpha = __builtin_amdgcn_exp2f(m_reg - mn); m_reg = mn;
    const float mneg = -m_reg;
#pragma unroll
    for (int r = 0; r < 16; ++r) { p0[r] = __builtin_amdgcn_exp2f(p0[r] + mneg); p1[r] = p1[r] + mneg; }
    return alpha;
}
__device__ __forceinline__ void finishSM(f32x16& p0, f32x16& p1, float alpha, float& l_reg, bf16x8& pa0, bf16x8& pa1, bf16x8& pa2, bf16x8& pa3) {
#pragma unroll
    for (int r = 0; r < 16; ++r) p1[r] = __builtin_amdgcn_exp2f(p1[r]);
    float ps = 0.f;
#pragma unroll
    for (int r = 0; r < 16; ++r) ps += p0[r];
#pragma unroll
    for (int r = 0; r < 16; ++r) ps += p1[r];
    { auto rr = __builtin_amdgcn_permlane32_swap(__float_as_uint(ps), __float_as_uint(ps), false, false);
      ps = __uint_as_float(rr[0]) + __uint_as_float(rr[1]); }
    l_reg = l_reg * alpha + ps;
#define PK4(P, B_, OUT) do { unsigned a0 = cvtpk(P[B_+0], P[B_+1]), a1 = cvtpk(P[B_+2], P[B_+3]);                          \
        unsigned b0 = cvtpk(P[B_+4], P[B_+5]), b1 = cvtpk(P[B_+6], P[B_+7]);                                             \
        auto r0 = __builtin_amdgcn_permlane32_swap(a0, b0, false, false); auto r1 = __builtin_amdgcn_permlane32_swap(a1, b1, false, false); \
        v4u w = {r0[0], r1[0], r0[1], r1[1]}; OUT = *reinterpret_cast<bf16x8*>(&w); } while (0)
    PK4(p0, 0, pa0); PK4(p0, 8, pa1); PK4(p1, 0, pa2); PK4(p1, 8, pa3);
#undef PK4
}
__device__ __forceinline__ float softmax_tile(f32x16& p0, f32x16& p1, float& m_reg, float& l_reg, bf16x8& pa0, bf16x8& pa1, bf16x8& pa2, bf16x8& pa3) {
    float pmax = p0[0];
#pragma unroll
    for (int r = 1; r < 16; ++r) pmax = fmaxf(pmax, p0[r]);
#pragma unroll
    for (int r = 0; r < 16; ++r) pmax = fmaxf(pmax, p1[r]);
    { auto rr = __builtin_amdgcn_permlane32_swap(__float_as_uint(pmax), __float_as_uint(pmax), false, false);
      pmax = fmaxf(__uint_as_float(rr[0]), __uint_as_float(rr[1])); }
    const bool need = !__all(pmax - m_reg <= 8.f);
    const float mn = need ? fmaxf(m_reg, pmax) : m_reg; const float alpha = __builtin_amdgcn_exp2f(m_reg - mn); m_reg = mn;
    const float mneg = -m_reg;
#pragma unroll
    for (int r = 0; r < 16; ++r) { p0[r] = __builtin_amdgcn_exp2f(p0[r] + mneg); p1[r] = __builtin_amdgcn_exp2f(p1[r] + mneg); }
    float ps = 0.f;
#pragma unroll
    for (int r = 0; r < 16; ++r) ps += p0[r];
#pragma unroll
    for (int r = 0; r < 16; ++r) ps += p1[r];
    { auto rr = __builtin_amdgcn_permlane32_swap(__float_as_uint(ps), __float_as_uint(ps), false, false);
      ps = __uint_as_float(rr[0]) + __uint_as_float(rr[1]); }
    l_reg = l_reg * alpha + ps;
#define PK4(P, B_, OUT) do { unsigned a0 = cvtpk(P[B_+0], P[B_+1]), a1 = cvtpk(P[B_+2], P[B_+3]);                          \
        unsigned b0 = cvtpk(P[B_+4], P[B_+5]), b1 = cvtpk(P[B_+6], P[B_+7]);                                             \
        auto r0 = __builtin_amdgcn_permlane32_swap(a0, b0, false, false); auto r1 = __builtin_amdgcn_permlane32_swap(a1, b1, false, false); \
        v4u w = {r0[0], r1[0], r0[1], r1[1]}; OUT = *reinterpret_cast<bf16x8*>(&w); } while (0)
    PK4(p0, 0, pa0); PK4(p0, 8, pa1); PK4(p1, 0, pa2); PK4(p1, 8, pa3);
#undef PK4
    return alpha;
}
template <int CTRL> __device__ __forceinline__ float dppx(float v) { return __builtin_bit_cast(float, __builtin_amdgcn_update_dpp(0, __builtin_bit_cast(int, v), CTRL, 0xF, 0xF, false)); }
__device__ __forceinline__ float lane_xor1(float v) { return dppx<0xB1>(v); }
__device__ __forceinline__ float half_sum32(float v) {
    v += dppx<0xB1>(v); v += dppx<0x4E>(v); v += dppx<0x141>(v); v += dppx<0x128>(v);
    auto s = __builtin_amdgcn_permlane16_swap(__float_as_uint(v), __float_as_uint(v), false, false);
    return __uint_as_float(s[0]) + __uint_as_float(s[1]);
}
struct AttnArgs {
    const bf16* buf; int ld;
    const unsigned long long* mask;
    bf16* O;
    const float* subg; float lam; float oscale;
    const float* gq;
    int var;
};
template <bool DIFF>
__device__ __forceinline__ void attn_unit(const AttnArgs& A, LAS unsigned char* lds, int u_b, int u_h, int u_q, gu32* qctr, volatile LAS unsigned* qslot) {
    const int VAR = PROBE_VAR ? A.var : 0;
    int tid_l = threadIdx.x; asm volatile("" : "+v"(tid_l));
    const int tid = tid_l, wid = __builtin_amdgcn_readfirstlane(tid >> 6), lane = tid & 63, r32 = lane & 31, hi = lane >> 5;
    const bool meta = u_b < 0;
    constexpr int ND0 = DIFF ? 4 : 8;
    const int qsub = DIFF ? (wid >> 1) : (wid & 1);
    const int qrow0 = meta ? NREAL + 32 * qsub : u_b * SEQ + (DIFF ? 128 : 64) * u_q + 32 * qsub;
    const int qpos0 = meta ? 32 * qsub : 16 + (DIFF ? 128 : 64) * u_q + 32 * qsub;
    const int nvalid = meta ? (qsub == 0 ? 16 : 0) : 32;
    const int qhead = DIFF ? (2 * u_h + (wid & 1)) : (4 * u_h + (wid >> 1));
    const int bhead = DIFF ? u_h : qhead;
    const int qcol = DIFF ? qhead * 64 : qhead * 128;
    const int kcol = 1024 + u_h * 128, vcol = (DIFF ? 2048 : 1280) + u_h * 128;
    const int kmapoff = DIFF ? (wid & 1) * 128 : 0;
    const int NT = meta ? 1 : (DIFF ? 2 * u_q + 3 : u_q + 2);
    const int my_nt = meta ? 1 : (DIFF ? 2 * u_q + 2 + (qsub >> 1) : NT);
    const int kbrow = meta ? 0 : u_b * SEQ;
    const LAS char* V_lds = (const LAS char*)lds + ALDS_V; const LAS char* K_lds = (const LAS char*)lds + ALDS_K;
    LAS float* wsf = (LAS float*)(lds + ALDS_WS) + wid * 64; LAS float* li_l = wsf; LAS float* al_l = wsf + 32;
    const LAS float* BT = (const LAS float*)(lds + ALDS_BT) + bhead * BT_N;
    const int sr = tid >> 4, sc = (tid & 15) * 8, vst0 = v_st(sr, sc), vst1 = v_st(32 + sr, sc), kws = KSWZ(sr, sc * 2);
    const int vb0 = (int)(unsigned)(size_t)V_lds + v_rd_base(lane);
    const int qrl = qrow0 + r32 < NVALID ? qrow0 + r32 : NVALID - 1;
    const int qpos = meta ? (qrl - NREAL) : qpos0 + r32;
    bf16x8 qr[ND0];
#pragma unroll
    for (int d0 = 0; d0 < ND0; ++d0) qr[d0] = *(const bf16x8*)(A.buf + (size_t)qrl * A.ld + qcol + d0 * 16 + hi * 8);
    if (!DIFF) {
        float ss = 0.f;
#pragma unroll
        for (int d0 = 0; d0 < ND0; ++d0)
#pragma unroll
            for (int e = 0; e < 8; ++e) { const float v = bf2f((unsigned short)qr[d0][e]); ss += v * v; }
        { auto rr = __builtin_amdgcn_permlane32_swap(__float_as_uint(ss), __float_as_uint(ss), false, false); ss = __uint_as_float(rr[0]) + __uint_as_float(rr[1]); }
        const float rq = __builtin_amdgcn_rsqf(ss * (1.f / 128.f) + EPS) * (0.08838834764831845f * L2E);
#pragma unroll
        for (int d0 = 0; d0 < ND0; ++d0) { const f32x4 ga = *(const f32x4*)(A.gq + d0 * 16 + hi * 8), gb = *(const f32x4*)(A.gq + d0 * 16 + hi * 8 + 4);
            v4u w; w.x = cvtpk(bf2f((unsigned short)qr[d0][0]) * rq * ga[0], bf2f((unsigned short)qr[d0][1]) * rq * ga[1]); w.y = cvtpk(bf2f((unsigned short)qr[d0][2]) * rq * ga[2], bf2f((unsigned short)qr[d0][3]) * rq * ga[3]);
            w.z = cvtpk(bf2f((unsigned short)qr[d0][4]) * rq * gb[0], bf2f((unsigned short)qr[d0][5]) * rq * gb[1]); w.w = cvtpk(bf2f((unsigned short)qr[d0][6]) * rq * gb[2], bf2f((unsigned short)qr[d0][7]) * rq * gb[3]);
            qr[d0] = *reinterpret_cast<bf16x8*>(&w); }
    }
    const unsigned long long* mrow = DIFF ? nullptr : A.mask + (size_t)qrl * MASKW;
    const float biasFar = __builtin_bit_cast(float, __builtin_amdgcn_readfirstlane(__builtin_bit_cast(int, BT[0])));
    float m_reg = -1e30f, l_reg = 0.f; f32x16 o[4] = {};
    bf16x8 st_k0, st_k1, st_v0, st_v1;
    const int half = wid >> 2;
#define KROW(t_, slot) ((VAR == 1 || (t_) == 0) ? NREAL + ((slot) < 16 ? (slot) : 15) : kbrow + 64 * ((t_) - 1) + (slot))
#define KLOAD(t_) do { st_k0 = *(const bf16x8*)(A.buf + (size_t)KROW(t_, sr) * A.ld + sc + kcol); st_k1 = *(const bf16x8*)(A.buf + (size_t)KROW(t_, 32 + sr) * A.ld + sc + kcol); } while (0)
#define VLOAD(t_) do { st_v0 = *(const bf16x8*)(A.buf + (size_t)KROW(t_, sr) * A.ld + sc + vcol); st_v1 = *(const bf16x8*)(A.buf + (size_t)KROW(t_, 32 + sr) * A.ld + sc + vcol); } while (0)
#define KWRITE(t_) do { const int kb_ = ((t_) & 1) * SHM_K; *(LAS bf16x8*)((LAS char*)K_lds + kb_ + kws) = st_k0; *(LAS bf16x8*)((LAS char*)K_lds + kb_ + kws + 32 * 256) = st_k1; } while (0)
#define VWRITE(t_) do { const int vb_ = ((t_) & 1) * SHM_V; *(LAS bf16x8*)((LAS char*)V_lds + vb_ + vst0) = st_v0; *(LAS bf16x8*)((LAS char*)V_lds + vb_ + vst1) = st_v1; } while (0)
#define TRRD(dst, off) asm volatile("ds_read_b64_tr_b16 %0, %1 offset:%2" : "=&v"(dst) : "v"(vbx_), "i"(off) : "memory")
#define PVR_I(d0, L0, L1, L2, L3, H0, H1, H2, H3) do { constexpr int b_ = v_rd_off(d0, 0, 0); \
        TRRD(L0, b_); TRRD(H0, b_ + 2048); TRRD(L1, b_ + 4096); TRRD(H1, b_ + 6144); TRRD(L2, b_ + 8192); TRRD(H2, b_ + 10240); TRRD(L3, b_ + 12288); TRRD(H3, b_ + 14336); } while (0)
#define PVM_I(d0, NW, L0, L1, L2, L3, H0, H1, H2, H3) do { asm volatile("s_waitcnt lgkmcnt(" #NW ")" : "+v"(L0), "+v"(L1), "+v"(L2), "+v"(L3), "+v"(H0), "+v"(H1), "+v"(H2), "+v"(H3) :: "memory"); SBAR();     \
        o[d0] = __builtin_amdgcn_mfma_f32_32x32x16_bf16(pa0, (bf16x8){L0[0], L0[1], L0[2], L0[3], H0[0], H0[1], H0[2], H0[3]}, o[d0], 0, 0, 0); \
        o[d0] = __builtin_amdgcn_mfma_f32_32x32x16_bf16(pa1, (bf16x8){L1[0], L1[1], L1[2], L1[3], H1[0], H1[1], H1[2], H1[3]}, o[d0], 0, 0, 0); \
        o[d0] = __builtin_amdgcn_mfma_f32_32x32x16_bf16(pa2, (bf16x8){L2[0], L2[1], L2[2], L2[3], H2[0], H2[1], H2[2], H2[3]}, o[d0], 0, 0, 0); \
        o[d0] = __builtin_amdgcn_mfma_f32_32x32x16_bf16(pa3, (bf16x8){L3[0], L3[1], L3[2], L3[3], H3[0], H3[1], H3[2], H3[3]}, o[d0], 0, 0, 0); } while (0)
#define PVR(d0, S) PVR_I(d0, S)
#define PVM(d0, NW, S) PVM_I(d0, NW, S)
#define VSA va0, va1, va2, va3, va4, va5, va6, va7
#define VSB vb_0, vb_1, vb_2, vb_3, vb_4, vb_5, vb_6, vb_7
#define PV_TILE(vt_) do { const int vbx_ = vb0 + ((vt_) & 1) * SHM_V; s16x4 VSA, VSB; \
        PVR(0, VSA); PVR(1, VSB); PVM(0, 8, VSA); PVR(2, VSA); PVM(1, 8, VSB); PVR(3, VSB); PVM(2, 8, VSA); PVM(3, 0, VSB); } while (0)
    { bf16x8 h_k0 = {}, h_k1 = {}; KLOAD(0); VLOAD(0);
      if (NT > 1) { h_k0 = *(const bf16x8*)(A.buf + (size_t)KROW(1, sr) * A.ld + sc + kcol); h_k1 = *(const bf16x8*)(A.buf + (size_t)KROW(1, 32 + sr) * A.ld + sc + kcol); }
      KWRITE(0); VWRITE(0);
      if (NT > 1) { *(LAS bf16x8*)((LAS char*)K_lds + SHM_K + kws) = h_k0; *(LAS bf16x8*)((LAS char*)K_lds + SHM_K + kws + 32 * 256) = h_k1; } }
    __syncthreads();
    if (half) __syncthreads();
    f32x16 p0, p1; bf16x8 pa0, pa1, pa2, pa3;
    unsigned nxt_ = 0u;
    for (int t = 0; t < NT; ++t) {
        if (t == NT - 1 && tid == 0) nxt_ = __hip_atomic_fetch_add(qctr, 1u, RLX_AGENT);
        const int kt = t + 1 + half, vt = t + half;
        const bool doK = kt < NT && kt >= 2, doV = vt < NT && vt >= 1;
        unsigned long long mw_ = 0ull; if (!DIFF) mw_ = mrow[t];
        if (doK) KLOAD(kt);
        if (doV) VLOAD(vt);
        const int kpos0 = t == 0 ? 0 : 16 + 64 * (t - 1);
        const bool nearT = kpos0 + 63 - qpos0 > -91;
        const float ci_ = (DIFF && t >= my_nt) ? -__builtin_inff() : (nearT ? 0.f : biasFar);
        SBAR(); if (VAR == 6) { _Pragma("unroll") for (int r = 0; r < 16; ++r) { p0[r] = ci_; p1[r] = ci_; } } else qkt<0, ND0>(p0, p1, K_lds + (t & 1) * SHM_K, r32, hi, qr, kmapoff, ci_);
        if (t > 0 && VAR != 4) { PV_TILE(t - 1); }
        __syncthreads();
        if (nearT) { const LAS float* bp = BT + (kpos0 - qpos + BT_OFF + 4 * hi);
#pragma unroll
            for (int r = 0; r < 16; ++r) { const int cr = (r & 3) + 8 * (r >> 2); p0[r] += bp[cr]; p1[r] += bp[cr + 32]; } }
        if (!DIFF) { const unsigned lo = (unsigned)mw_ >> (4 * hi), hw = (unsigned)(mw_ >> 32) >> (4 * hi);
#pragma unroll
            for (int r = 0; r < 16; ++r) { const int cr = (r & 3) + 8 * (r >> 2);
                const int m0 = ((int)(lo << (31 - cr))) >> 31, m1 = ((int)(hw << (31 - cr))) >> 31;
                p0[r] = __uint_as_float((__float_as_uint(p0[r]) & (unsigned)m0) | (0xff800000u & ~(unsigned)m0));
                p1[r] = __uint_as_float((__float_as_uint(p1[r]) & (unsigned)m1) | (0xff800000u & ~(unsigned)m1)); } }
        else if (t == 0) { const float NEG = -__builtin_inff();
#pragma unroll
            for (int r = 8; r < 16; ++r) p0[r] = NEG;
#pragma unroll
            for (int r = 0; r < 16; ++r) p1[r] = NEG; }
        float alpha = 1.f;
        if (VAR == 7) { v4u w_ = {__float_as_uint(p0[0]), __float_as_uint(p0[5]), __float_as_uint(p1[3]), __float_as_uint(p1[9])}; pa0 = *reinterpret_cast<bf16x8*>(&w_); pa1 = pa0; pa2 = pa0; pa3 = pa0; }
        else alpha = softmax_tile(p0, p1, m_reg, l_reg, pa0, pa1, pa2, pa3);
        if (__any(alpha < 1.f)) { if (hi == 0) al_l[r32] = alpha; asm volatile("s_waitcnt lgkmcnt(0)" ::: "memory");
#pragma unroll
            for (int d_ = 0; d_ < 4; ++d_)
#pragma unroll
                for (int r = 0; r < 16; ++r) o[d_][r] *= al_l[crow(r, hi)]; }
        if (doK) KWRITE(kt);
        if (doV) VWRITE(vt);
        __syncthreads();
    }
    PV_TILE(NT - 1);
    if (tid == 0) *qslot = nxt_;
    if (!half) __syncthreads();
    __syncthreads();
#undef KROW
#undef KLOAD
#undef VLOAD
#undef KWRITE
#undef VWRITE
#undef TRRD
#undef PVR_I
#undef PVM_I
#undef PVR
#undef PVM
#undef VSA
#undef VSB
#undef PV_TILE
    if (hi == 0) li_l[r32] = l_reg; asm volatile("s_waitcnt lgkmcnt(0)" ::: "memory");
    float rli[16];
#pragma unroll
    for (int r = 0; r < 16; ++r) rli[r] = __builtin_amdgcn_rcpf(li_l[crow(r, hi)]);
    if (!DIFF) {
        bf16* Ow = A.O + (size_t)(VAR ? (qrow0 & 4095) : qrow0) * DM + qhead * 128;
#pragma unroll
        for (int r = 0; r < 16; ++r) { const int orow = crow(r, hi);
#pragma unroll
            for (int d0 = 0; d0 < 4; ++d0) { const float v = o[d0][r] * rli[r]; const float vn = lane_xor1(v);
                if ((r32 & 1) == 0 && orow < nvalid) *(unsigned*)(Ow + (size_t)orow * DM + d0 * 32 + r32) = cvtpk(v, vn); } }
        __syncthreads();
    } else {
        LAS float* X = (LAS float*)lds + (wid >> 1) * 4096;
        const int map = wid & 1;
        if (map == 1) {
#pragma unroll
            for (int d0 = 0; d0 < 4; ++d0)
#pragma unroll
                for (int r = 0; r < 16; ++r) X[(d0 * 16 + r) * 64 + lane] = o[d0][r] * rli[r] * A.lam;
        }
        __syncthreads();
        if (map == 0) {
            float g4[4];
#pragma unroll
            for (int d0 = 0; d0 < 4; ++d0) g4[d0] = A.subg[d0 * 32 + r32] * A.oscale;
            bf16* Ow = A.O + (size_t)(VAR ? (qrow0 & 4095) : qrow0) * DM + u_h * 128;
#pragma unroll
            for (int r = 0; r < 16; ++r) { const int orow = crow(r, hi);
                float dv[4]; float ss = 0.f;
#pragma unroll
                for (int d0 = 0; d0 < 4; ++d0) { dv[d0] = o[d0][r] * rli[r] - X[(d0 * 16 + r) * 64 + lane]; ss += dv[d0] * dv[d0]; }
                ss = half_sum32(ss);
                const float rs = __builtin_amdgcn_rsqf(ss * (1.f / 128.f) + EPS);
#pragma unroll
                for (int d0 = 0; d0 < 4; ++d0) { const float v = dv[d0] * rs * g4[d0]; const float vn = lane_xor1(v);
                    if ((r32 & 1) == 0 && orow < nvalid) *(unsigned*)(Ow + (size_t)orow * DM + d0 * 32 + r32) = cvtpk(v, vn); } }
        }
        __syncthreads();
    }
}
template <bool DIFF>
__device__ __forceinline__ void attn_phase(Frame& F, const AttnArgs& A, const float* bt_global, gu32* qhead) {
    for (int i = F.tid; i < 8 * BT_N; i += NWAVES * 64) ((LAS float*)(F.lds + ALDS_BT))[i] = bt_global[i];
    __syncthreads();
    constexpr int NQT = DIFF ? 16 : 32, NH = DIFF ? 8 : 2, NREALU = NB * NH * NQT, NU = NREALU + NH;
    if (F.tid == 0) F.MISC[4] = __hip_atomic_fetch_add(qhead, 1u, RLX_AGENT);
    for (;;) {
        __syncthreads();
        const int u = __builtin_amdgcn_readfirstlane((int)F.MISC[4]);
        __syncthreads();
        if (u >= NU) break;
        const bool real = u >= NH; const int ur = u - NH, bh = ur % (NB * NH);
        attn_unit<DIFF>(A, F.lds, real ? bh / NH : -1, real ? bh % NH : u, real ? NQT - 1 - ur / (NB * NH) : 0, qhead, F.MISC + 4);
    }
}

constexpr int N_PHASES = 19;
__global__ void __launch_bounds__(NWAVES * 64, 2) yoco_fwd(Params P) {
    extern __shared__ __attribute__((aligned(16))) unsigned char lds[];
    Frame F;
    F.lds = (LAS unsigned char*)lds;
    F.MISC = (volatile LAS unsigned*)(F.lds + MISC_OFF);
    F.tid = threadIdx.x; F.lane = F.tid & 63; F.wave = __builtin_amdgcn_readfirstlane(F.tid >> 6);
    F.G = gridDim.x;
    unsigned char* ws = P.ws;
    F.ctl = (gu32*)(ws + WS_CTL);
    for (int u = F.tid; u < (LDS_BYTES - LDSCTL_OFF) / 4; u += NWAVES * 64) ((LAS unsigned*)(F.lds + LDSCTL_OFF))[u] = 0u;
    __syncthreads();
    const int lo = P.ph_lo, hi = P.ph_hi;
    const bool use_bar = (hi - lo) > 1;
    XcdBarrier bar; bar.bar = (unsigned*)(F.ctl + CW_BAR); bar.x = 0; bar.st = nullptr;
    if (use_bar) bar = xcd_barrier_post((unsigned*)(F.ctl + CW_BAR), F.MISC + 8);
#define IN(k) (lo <= (k) && (k) < hi)
#define RELAUNDER() asm volatile("" : "+v"(F.tid), "+v"(F.lane))
#define SEAM(k) do { if (IN(k) && IN((k) + 1)) xcd_barrier(bar); } while (0)
    bf16* const X0 = (bf16*)(ws + WS_X0); bf16* const X1 = (bf16*)(ws + WS_X1);
    bf16* const PROJ = (bf16*)(ws + WS_PROJ); bf16* const KVQ = (bf16*)(ws + WS_KVQ); bf16* const G = (bf16*)(ws + WS_G);
    float* const SC = (float*)(ws + WS_SC); unsigned long long* const MASK = (unsigned long long*)(ws + WS_MASK);
    float* const UH = (float*)(ws + WS_UH); float* const HMETA = (float*)(ws + WS_HMETA); const float* const BTG = (const float*)(ws + WS_BT);
    const int bid = (int)blockIdx.x;
    float* const RS0 = (float*)(ws + WS_PS); float* const RS1 = RS0 + 262144; float* const RS2 = RS1 + 262144;
    float* const RM0 = (float*)(ws + WS_PSM); float* const RM1 = RM0 + 4096; float* const RM2 = RM1 + 4096;

    if (IN(0)) { RELAUNDER(); p0_prologue(F, P); } SEAM(0);
    if (IN(1)) { RELAUNDER(); meta_store_bf16(F, X0 + (size_t)NREAL * DM, (const bf16*)(ws + WS_WIN), PROJ, PROJ_LD, PROJ_LD, 9, nullptr);
        idxcols_gemm(F, X0, (const bf16*)(ws + WS_WIN), PROJ);
        pg8::Gemm g{X0, (const bf16*)(ws + WS_WIN), NREAL, 2048, DM}; pg8::StaticOrder S; S.init(NREAL, 2048, F.G, bid);
        pg8::EpiBf16G E{PROJ, PROJ_LD, 2048, nullptr};
        pg8::gemm_phase<pg8::EpiBf16G, pg8::StaticOrder, PG8_ALIGN, PG8_SP2>(F.lds, g, S, E); } SEAM(1);
    if (IN(2)) { RELAUNDER(); knorm0_phase(F, PROJ, P.kn_a); }
    if (IN(3)) { RELAUNDER(); idxsel_phase(F, PROJ, MASK); } SEAM(3);
    if (IN(4)) { RELAUNDER(); AttnArgs A{PROJ, PROJ_LD, MASK, X1, nullptr, 0.f, 0.f, P.qn_a, 0};
#if PROBE_VAR && PROBE_VAR_A
        _Pragma("nounroll") for (int rep = 0; rep < 2; ++rep) { A.var = rep ? 0 : PROBE_VAR; A.O = rep ? X1 : (bf16*)(ws + 190 * MiB); attn_phase<false>(F, A, BTG, F.ctl + CW_Q0 + 1024 * (1 - rep)); }
#else
        attn_phase<false>(F, A, BTG, F.ctl + CW_Q0);
#endif

#if DUP_ATTN
        attn_phase<false>(F, A, BTG, F.ctl + CW_Q0 + 256);
#endif
        } SEAM(4);
    if (IN(5)) { RELAUNDER(); meta_resid(F, X1 + (size_t)NREAL * DM, DM, (const bf16*)(ws + WS_WOA), P.meta, nullptr, X0, RM0);
        pg8::Gemm g{X1, (const bf16*)(ws + WS_WOA), NREAL, DM, DM}; pg8::StaticOrder S; S.init(NREAL, DM, F.G, bid);
        pg8::EpiResid<false> E{P.x, nullptr, X0, RS0};
        pg8::gemm_phase<pg8::EpiResid<false>, pg8::StaticOrder, PG8_ALIGN, PG8_SP2>(F.lds, g, S, E); } SEAM(5);
    if (IN(7)) { RELAUNDER();
        pg8::Gemm g{X0, (const bf16*)(ws + WS_WUP0), NREAL, 2 * DFF, DM}; pg8::StaticOrder S; S.init(NREAL, 2 * DFF, F.G, bid);
        pg8::EpiConv E{G, UH, P.conv_w, P.conv_b, RS0};
        pg8::gemm_phase<pg8::EpiConv, pg8::StaticOrder, PG8_ALIGN, PG8_SP2>(F.lds, g, S, E);
        if (bid >= 128) { __syncthreads();
            meta_upconv(F, X0 + (size_t)NREAL * DM, (const bf16*)(ws + WS_WUP0), G, UH, P.conv_w, P.conv_b, RM0, 22 * (bid - 128));
            meta_upconv(F, X0 + (size_t)NREAL * DM, (const bf16*)(ws + WS_WUP0), G, UH, P.conv_w, P.conv_b, RM0, 22 * (bid - 128) + 11);
            convert_l1_weights(F, P, (bid - 128) * NWAVES + F.wave, 128 * NWAVES); }
        } SEAM(7);
    if (IN(9)) { RELAUNDER(); meta_resid(F, G + (size_t)NREAL * DFF, DFF, (const bf16*)(ws + WS_WDN0), nullptr, X0, X1, RM1);
        pg8::Gemm g{G, (const bf16*)(ws + WS_WDN0), NREAL, DM, DFF}; pg8::StaticOrder S; S.init(NREAL, DM, F.G, bid);
        { pg8::Unit u0; if (S.next(0, u0)) fixup_panel(F, UH, G, P.conv_w, P.conv_b, u0.pm); }
        pg8::EpiResid<true> E{X0, nullptr, X1, RS1};
        pg8::gemm_phase<pg8::EpiResid<true>, pg8::StaticOrder, PG8_ALIGN, PG8_SP2>(F.lds, g, S, E); } SEAM(9);
#if PROBE_DRY
    if (IN(10)) { RELAUNDER(); pg8::Gemm g{G, (const bf16*)(ws + WS_WDN0), NREAL, DM, DFF}; pg8::StaticOrder S; S.init(NREAL, DM, F.G, bid);
        pg8::EpiResid<true> E{X0, (float*)(ws + 236 * MiB), nullptr, nullptr};
        pg8::gemm_phase<pg8::EpiResid<true>, pg8::StaticOrder, PG8_ALIGN, PG8_SP2>(F.lds, g, S, E); }
#endif
    if (IN(11)) { RELAUNDER(); meta_kvq(F, X1 + (size_t)NREAL * DM, (const bf16*)(ws + WS_WKVQ), KVQ, RM1, P.qn_b, P.kn_b, 0.125f * L2E);
        pg8::Gemm g{X1, (const bf16*)(ws + WS_WKVQ), NREAL, KVQ_LD, DM}; pg8::StaticOrder S; S.init(NREAL, KVQ_LD, F.G, bid);
        pg8::EpiKVQ E{KVQ, RS1, P.qn_b, P.kn_b, 0.125f * L2E};
        pg8::gemm_phase<pg8::EpiKVQ, pg8::StaticOrder, PG8_ALIGN, PG8_SP2>(F.lds, g, S, E); } SEAM(11);
    if (IN(13)) { RELAUNDER(); const float lam = *(const float*)(ws + WS_LAM); const float lam_init = 0.8f - 0.6f * 0.7408182206817179f;
        AttnArgs A{KVQ, KVQ_LD, nullptr, X0, P.subln_b, lam, 1.f - lam_init, nullptr, 0};
#if PROBE_VAR && !PROBE_VAR_A
        _Pragma("nounroll") for (int rep = 0; rep < 2; ++rep) { A.var = rep ? 0 : PROBE_VAR; A.O = rep ? X0 : (bf16*)(ws + 214 * MiB); attn_phase<true>(F, A, BTG, F.ctl + CW_Q1 + 1024 * (1 - rep)); }
#else
        attn_phase<true>(F, A, BTG, F.ctl + CW_Q1);
#endif

#if DUP_ATTN
        attn_phase<true>(F, A, BTG, F.ctl + CW_Q1 + 256);
#endif
        } SEAM(13);
    if (IN(14)) { RELAUNDER(); meta_resid(F, X0 + (size_t)NREAL * DM, DM, (const bf16*)(ws + WS_WOB), nullptr, X1, X1, RM2);
        pg8::Gemm g{X0, (const bf16*)(ws + WS_WOB), NREAL, DM, DM}; pg8::StaticOrder S; S.init(NREAL, DM, F.G, bid);
        pg8::EpiResid<true> E{X1, nullptr, X1, RS2};
        pg8::gemm_phase<pg8::EpiResid<true>, pg8::StaticOrder, PG8_ALIGN, PG8_SP2>(F.lds, g, S, E); } SEAM(14);
    if (IN(16)) { RELAUNDER();
        pg8::Gemm g{X1, (const bf16*)(ws + WS_WUP1), NREAL, 2 * DFF, DM}; pg8::StaticOrder S; S.init(NREAL, 2 * DFF, F.G, bid);
        pg8::EpiConv E{G, UH, P.conv_w + 3 * 2 * DFF, P.conv_b + 2 * DFF, RS2};
        pg8::gemm_phase<pg8::EpiConv, pg8::StaticOrder, PG8_ALIGN, PG8_SP2>(F.lds, g, S, E);
        if (bid >= 128) { __syncthreads();
            meta_upconv(F, X1 + (size_t)NREAL * DM, (const bf16*)(ws + WS_WUP1), G, UH, P.conv_w + 3 * 2 * DFF, P.conv_b + 2 * DFF, RM2, 22 * (bid - 128));
            meta_upconv(F, X1 + (size_t)NREAL * DM, (const bf16*)(ws + WS_WUP1), G, UH, P.conv_w + 3 * 2 * DFF, P.conv_b + 2 * DFF, RM2, 22 * (bid - 128) + 11); }
        } SEAM(16);
    if (IN(18)) { RELAUNDER(); pg8::Gemm g{G, (const bf16*)(ws + WS_WDN1), NREAL, DM, DFF}; pg8::StaticOrder S; S.init(NREAL, DM, F.G, bid);
        { pg8::Unit u0; if (S.next(0, u0)) fixup_panel(F, UH, G, P.conv_w + 3 * 2 * DFF, P.conv_b + 2 * DFF, u0.pm); }
        pg8::EpiResid<true> E{X1, P.out, nullptr, nullptr};
        pg8::gemm_phase<pg8::EpiResid<true>, pg8::StaticOrder, PG8_ALIGN, PG8_SP2>(F.lds, g, S, E); }
#undef IN
#undef RELAUNDER
#undef SEAM
}

extern "C" void kernel_launch(void* const* d_in, const int* in_sizes, int n_in, void* d_out, int out_size, void* d_ws, size_t ws_size, hipStream_t stream) {
    static int grid = 0;
    if (grid == 0) {
        if (n_in != 24 || false || in_sizes[0] != NREAL * DM || out_size != NREAL * DM || ws_size < WS_END) { fprintf(stderr, "kernel_launch: unexpected shapes (n_in %d, in0 %d, out %d, ws %zu)\n", n_in, n_in > 0 ? in_sizes[0] : -1, out_size, ws_size); grid = -1; return; }
        int dev = 0, cus = 0, per_cu = 0;
        if (hipGetDevice(&dev) != hipSuccess || hipDeviceGetAttribute(&cus, hipDeviceAttributeMultiprocessorCount, dev) != hipSuccess) { grid = -1; return; }
        if (hipFuncSetAttribute((const void*)yoco_fwd, hipFuncAttributeMaxDynamicSharedMemorySize, LDS_BYTES) != hipSuccess) { fprintf(stderr, "kernel_launch: hipFuncSetAttribute failed\n"); grid = -1; return; }
        if (hipOccupancyMaxActiveBlocksPerMultiprocessor(&per_cu, (const void*)yoco_fwd, NWAVES * 64, LDS_BYTES) != hipSuccess || per_cu < 1)
            fprintf(stderr, "kernel_launch: note: occupancy query reports %d workgroups per CU\n", per_cu);
        (void)hipGetLastError();
        grid = cus;
        if (grid != 256) { fprintf(stderr, "kernel_launch: this kernel is laid out for 256 CUs (got %d)\n", grid); grid = -1; return; }
    }
    if (grid < 0) return;
    if (hipMemsetAsync((char*)d_ws + WS_CTL, 0, CTL_ZERO_BYTES, stream) != hipSuccess) return;
    Params p{};
    const float** pf = (const float**)&p;
    for (int i = 0; i < 24; ++i) pf[i] = (const float*)d_in[i];
    p.out = (float*)d_out; p.ws = (unsigned char*)d_ws;
#if MK_N_LAUNCHES == 1
    p.ph_lo = 0; p.ph_hi = N_PHASES;
    hipLaunchKernelGGL(yoco_fwd, dim3(grid), dim3(NWAVES * 64), LDS_BYTES, stream, p);
#else
    static const int seq[] = { PROBE_SEQ };
    for (unsigned i = 0; i < sizeof(seq) / sizeof(seq[0]); ++i) { const int k = seq[i];
        if (k == 4) (void)hipMemsetAsync((char*)d_ws + WS_CTL + CW_Q0 * 4, 0, 2048, stream);
        if (k == 13) (void)hipMemsetAsync((char*)d_ws + WS_CTL + CW_Q1 * 4, 0, 2048, stream);
        p.ph_lo = k; p.ph_hi = k + 1; hipLaunchKernelGGL(yoco_fwd, dim3(grid), dim3(NWAVES * 64), LDS_BYTES, stream, p); }
#endif
}
```
